# Optimizing an MI355X kernel written in HIP

```python
import jax, jax.numpy as jnp
from jax import lax
import numpy as np

D_MODEL = 1024
BATCH = 4
SEQ = 8192
DEPTH = 2

CHUNK = 64
D_MIX = D_MODEL
A_WIDTH = D_MIX // 4
A_HEADS = 4
A_HEAD_DIM = A_WIDTH // A_HEADS
A_BLOCK = 128
POOL_WINDOWS = (2, 4, 8, 16)
B_WIDTH = D_MIX // 4
B_GROUP_DIM = B_WIDTH // len(POOL_WINDOWS)
C_WIDTH = D_MIX - A_WIDTH - B_WIDTH
C_HEADS = 8
C_HEAD_DIM = C_WIDTH // C_HEADS
ROPE_BASE = 10000.0
IN_COLS = 2 * A_WIDTH + B_WIDTH + 4 * C_WIDTH
D_FF = ((8 * D_MODEL // 3 + 127) // 128) * 128
CONV_WIDTH = 3
EPS = 1e-6

kernel_name = "hybrid_gmlp_pool_retention_convffn"


def rms_norm(x, g):
    xf = x.astype(jnp.float32)
    y = xf * lax.rsqrt(jnp.mean(xf * xf, axis=-1, keepdims=True) + EPS)
    return (y * g.astype(jnp.float32)).astype(x.dtype)


def spatial_gating(z, vnorm_g, ws, bs):
    bsz, s_len, _ = z.shape
    u, v = jnp.split(z, 2, axis=-1)
    v = rms_norm(v, vnorm_g)
    nb = s_len // A_BLOCK
    v = v.reshape(bsz, nb, A_BLOCK, A_HEADS, A_HEAD_DIM)
    chunk_id = jnp.arange(A_BLOCK) // CHUNK
    mask = chunk_id[:, None] >= chunk_id[None, :]
    w = jnp.where(mask[None], ws, jnp.zeros_like(ws))
    sv = jnp.einsum('hts,bnshd->bnthd', w, v) + bs.T[None, None, :, :, None]
    return u * sv.reshape(bsz, s_len, A_WIDTH)


def multiscale_pool(xb, w_grp, scale):
    bsz, s_len, _ = xb.shape
    xf = xb.astype(jnp.float32)
    cs = jnp.concatenate([jnp.zeros((bsz, 1, B_WIDTH), jnp.float32), jnp.cumsum(xf, axis=1)], axis=1)
    t = jnp.arange(s_len)
    outs = []
    for gi, win in enumerate(POOL_WINDOWS):
        sl = slice(gi * B_GROUP_DIM, (gi + 1) * B_GROUP_DIM)
        lo = jnp.maximum(t + 1 - win, 0)
        cnt = (t + 1 - lo).astype(jnp.float32)
        outs.append((cs[:, 1:, sl] - cs[:, lo, sl]) / cnt[None, :, None])
    pooled = jnp.concatenate(outs, axis=-1).astype(xb.dtype) - xb
    pooled = pooled.reshape(bsz, s_len, len(POOL_WINDOWS), B_GROUP_DIM)
    y = jnp.einsum('bsgc,gcd->bsgd', pooled, w_grp).reshape(bsz, s_len, B_WIDTH)
    return y * scale


def rotary(x, pos):
    half = x.shape[-1] // 2
    inv = ROPE_BASE ** (-jnp.arange(half, dtype=jnp.float32) / half)
    ang = pos.astype(jnp.float32)[:, None] * inv[None, :]
    cos = jnp.cos(ang)[None, :, None, :]
    sin = jnp.sin(ang)[None, :, None, :]
    xf = x.astype(jnp.float32)
    x1, x2 = xf[..., :half], xf[..., half:]
    return jnp.concatenate([x1 * cos - x2 * sin, x2 * cos + x1 * sin], axis=-1).astype(x.dtype)


def retention(q, k, v, g, norm_g):
    bsz, s_len, _ = q.shape
    n_chunks = s_len // CHUNK
    dt = q.dtype
    pos = jnp.arange(s_len)
    q = rotary(q.reshape(bsz, s_len, C_HEADS, C_HEAD_DIM), pos) * (C_HEAD_DIM ** -0.5)
    k = rotary(k.reshape(bsz, s_len, C_HEADS, C_HEAD_DIM), pos)
    v = v.reshape(bsz, s_len, C_HEADS, C_HEAD_DIM)
    log_gamma = jnp.log1p(-jnp.exp2(-5.0 - jnp.arange(C_HEADS, dtype=jnp.float32)))
    idx = jnp.arange(CHUNK, dtype=jnp.float32)
    d_intra = jnp.exp(log_gamma[:, None, None] * jnp.abs(idx[:, None] - idx[None, :])).astype(dt)
    k_dec = jnp.exp(log_gamma[None, :] * (CHUNK - 1 - idx)[:, None]).astype(dt)
    q_dec = jnp.exp(log_gamma[None, :] * (idx + 1)[:, None]).astype(dt)
    chunk_dec = jnp.exp(log_gamma * CHUNK).astype(dt)
    qc = q.reshape(bsz, n_chunks, CHUNK, C_HEADS, C_HEAD_DIM)
    kc = k.reshape(bsz, n_chunks, CHUNK, C_HEADS, C_HEAD_DIM)
    vc = v.reshape(bsz, n_chunks, CHUNK, C_HEADS, C_HEAD_DIM)
    scores = jnp.einsum('bnthd,bnshd->bnhts', qc, kc) * d_intra
    y_intra = jnp.einsum('bnhts,bnshe->bnthe', scores, vc)
    kv = jnp.einsum('bnshd,bnshe->nbhde', kc * k_dec[:, :, None], vc)

    def step(state, kv_n):
        return state * chunk_dec[None, :, None, None] + kv_n, state

    _, s_prev = lax.scan(step, jnp.zeros(kv.shape[1:], kv.dtype), kv)
    y_cross = jnp.einsum('bnthd,nbhde->bnthe', qc * q_dec[:, :, None], s_prev)
    y = (y_intra + y_cross).reshape(bsz, s_len, C_HEADS, C_HEAD_DIM)
    yf = y.astype(jnp.float32)
    mu = jnp.mean(yf, axis=-1, keepdims=True)
    var = jnp.mean(jnp.square(yf - mu), axis=-1, keepdims=True)
    yf = (yf - mu) * lax.rsqrt(var + EPS)
    y = (yf.reshape(bsz, s_len, C_WIDTH) * norm_g.astype(jnp.float32)).astype(dt)
    return jax.nn.silu(g) * y


def conv_ffn(h, w_up, conv_w, conv_b, w_down):
    up = h @ w_up
    s_len = up.shape[1]
    padded = jnp.pad(up, ((0, 0), (CONV_WIDTH - 1, 0), (0, 0)))
    conv = conv_b + padded[:, 0:s_len] * conv_w[0]
    for j in range(1, CONV_WIDTH):
        conv = conv + padded[:, j:j + s_len] * conv_w[j]
    gate, val = jnp.split(conv, 2, axis=-1)
    return (jax.nn.silu(gate) * val) @ w_down


def setup_inputs(seed: int = 0) -> dict:
    key = jax.random.key(seed)
    ks = jax.random.split(key, 20)
    f32 = jnp.float32
    nrm = lambda k, shape, s: jax.random.normal(k, shape, f32) * s
    return {
        "x": jax.random.normal(ks[0], (BATCH, SEQ, D_MODEL), f32),
        "norm1_g": 1.0 + nrm(ks[1], (DEPTH, D_MODEL), 0.05),
        "w_in": nrm(ks[2], (DEPTH, D_MODEL, IN_COLS), D_MODEL ** -0.5),
        "a_vnorm_g": 1.0 + nrm(ks[3], (DEPTH, A_WIDTH), 0.05),
        "a_ws": nrm(ks[4], (DEPTH, A_HEADS, A_BLOCK, A_BLOCK), 0.5 * A_BLOCK ** -0.5),
        "a_bs": 1.0 + nrm(ks[5], (DEPTH, A_HEADS, A_BLOCK), 0.1),
        "b_w": nrm(ks[6], (DEPTH, len(POOL_WINDOWS), B_GROUP_DIM, B_GROUP_DIM), B_GROUP_DIM ** -0.5),
        "b_scale": 1.0 + nrm(ks[7], (DEPTH, B_WIDTH), 0.1),
        "c_norm_g": 1.0 + nrm(ks[8], (DEPTH, C_WIDTH), 0.05),
        "w_out": nrm(ks[9], (DEPTH, D_MIX, D_MODEL), D_MIX ** -0.5),
        "norm2_g": 1.0 + nrm(ks[10], (DEPTH, D_MODEL), 0.05),
        "w_up": nrm(ks[11], (DEPTH, D_MODEL, 2 * D_FF), D_MODEL ** -0.5),
        "conv_w": nrm(ks[12], (DEPTH, CONV_WIDTH, 2 * D_FF), CONV_WIDTH ** -0.5),
        "conv_b": nrm(ks[13], (DEPTH, 2 * D_FF), 0.02),
        "w_down": nrm(ks[14], (DEPTH, D_FF, D_MODEL), D_FF ** -0.5),
        "final_g": 1.0 + nrm(ks[15], (D_MODEL,), 0.05),
    }


def reference(x, norm1_g, w_in, a_vnorm_g, a_ws, a_bs, b_w, b_scale, c_norm_g,
              w_out, norm2_g, w_up, conv_w, conv_b, w_down, final_g):
    splits = [2 * A_WIDTH, 2 * A_WIDTH + B_WIDTH, 2 * A_WIDTH + B_WIDTH + C_WIDTH,
              2 * A_WIDTH + B_WIDTH + 2 * C_WIDTH, 2 * A_WIDTH + B_WIDTH + 3 * C_WIDTH]
    for l in range(DEPTH):
        h = rms_norm(x, norm1_g[l])
        proj = h @ w_in[l]
        za, xb, q, k, v, g = jnp.split(proj, splits, axis=-1)
        ya = spatial_gating(jax.nn.gelu(za), a_vnorm_g[l], a_ws[l], a_bs[l])
        yb = multiscale_pool(xb, b_w[l], b_scale[l])
        yc = retention(q, k, v, g, c_norm_g[l])
        x = x + jnp.concatenate([ya, yb, yc], axis=-1) @ w_out[l]
        x = x + conv_ffn(rms_norm(x, norm2_g[l]), w_up[l], conv_w[l], conv_b[l], w_down[l])
    return rms_norm(x, final_g)
```

```cpp
#include <hip/hip_runtime.h>
#include <hip/hip_cooperative_groups.h>
#include <cstdio>
namespace cg = cooperative_groups;
#ifndef DUP_SYNC
#define DUP_SYNC 0
#endif
#ifndef DUP_MIX
#define DUP_MIX 0
#endif
#ifndef DUP_MISC
#define DUP_MISC 0
#endif
#ifndef DUP_G13
#define DUP_G13 0
#endif
#define GSYNC() do { xcd_barrier((unsigned*)(pt.ws() + WS_BAR), (volatile LAS unsigned*)(ldsl + LDS_TAB + 192)); if (DUP_SYNC) xcd_barrier((unsigned*)(pt.ws() + WS_BAR), (volatile LAS unsigned*)(ldsl + LDS_TAB + 192)); } while (0)

typedef unsigned short bf16_t;
typedef short bf16x8 __attribute__((ext_vector_type(8)));
typedef float f32x4 __attribute__((ext_vector_type(4)));
typedef float f32x2 __attribute__((ext_vector_type(2)));
typedef unsigned u32x4 __attribute__((ext_vector_type(4)));
typedef unsigned u32x2 __attribute__((ext_vector_type(2)));
#define LAS __attribute__((address_space(3)))
#define GAS __attribute__((address_space(1)))

constexpr int MTOK = 32768, DM = 1024, SEQL = 8192, NIN = 2816, NUP = 5632, DFF = 2816, NLAYER = 2;
constexpr int NTHR = 512;
constexpr int LDS_X    = 131072;
constexpr int LDSX_SS  = 0;
constexpr int LDSX_W   = 16384;
constexpr int LDS_TAB  = LDS_X + 24576;
constexpr int LDS_BYTES = LDS_TAB + 256;
constexpr int PC_U = 0, PC_V = 256, PC_XB = 512, PC_Q = 768, PC_K = 1280, PC_VV = 1792, PC_G = 2304;

constexpr size_t WS_WIN  = 0;
constexpr size_t WS_WOUT = WS_WIN  + (size_t)NLAYER * NIN * DM * 2;
constexpr size_t WS_WUP  = WS_WOUT + (size_t)NLAYER * DM * DM * 2;
constexpr size_t WS_WDN  = WS_WUP  + (size_t)NLAYER * NUP * DM * 2;
constexpr size_t WS_AWS  = WS_WDN  + (size_t)NLAYER * DM * DFF * 2;
constexpr size_t WS_BWT  = WS_AWS  + (size_t)NLAYER * 4 * 128 * 128 * 2;
constexpr size_t WS_XB   = WS_BWT  + (size_t)NLAYER * 4 * 64 * 64 * 2;
constexpr size_t WS_SS   = WS_XB   + (size_t)MTOK * DM * 2;
constexpr size_t WS_PROJ = WS_SS   + (size_t)MTOK * 16 * 4;
constexpr size_t WS_Y    = WS_PROJ + (size_t)MTOK * NIN * 2;
constexpr size_t WS_KVS  = WS_Y    + (size_t)MTOK * DM * 2;
constexpr size_t WS_HALO = WS_KVS  + (size_t)256 * 8 * 4096 * 4;
constexpr size_t WS_BAR  = WS_HALO + (size_t)512 * 4 * NUP * 4;
constexpr size_t WS_END  = WS_BAR + 16384;

struct Params {
    const float* x; const float* norm1_g; const float* w_in; const float* a_vnorm_g; const float* a_ws; const float* a_bs;
    const float* b_w; const float* b_scale; const float* c_norm_g; const float* w_out; const float* norm2_g; const float* w_up;
    const float* conv_w; const float* conv_b; const float* w_down; const float* final_g;
    float* out; unsigned char* ws;
};


struct PT {
    const LAS unsigned long long* t;
    __device__ __forceinline__ unsigned long long g(int i) const {
        const unsigned long long v = t[i];
        const unsigned lo = __builtin_amdgcn_readfirstlane((unsigned)v), hi = __builtin_amdgcn_readfirstlane((unsigned)(v >> 32));
        return ((unsigned long long)hi << 32) | lo;
    }
    __device__ __forceinline__ const float* x() const { return (const float*)(GAS const float*)g(0); }
    __device__ __forceinline__ const float* raw(int i) const { return (const float*)(GAS const float*)g(i); }
    __device__ __forceinline__ const float* a_vnorm_g() const { return (const float*)(GAS const float*)g(3); }
    __device__ __forceinline__ const float* a_bs() const { return (const float*)(GAS const float*)g(5); }
    __device__ __forceinline__ const float* b_scale() const { return (const float*)(GAS const float*)g(7); }
    __device__ __forceinline__ const float* c_norm_g() const { return (const float*)(GAS const float*)g(8); }
    __device__ __forceinline__ const float* conv_w() const { return (const float*)(GAS const float*)g(12); }
    __device__ __forceinline__ const float* conv_b() const { return (const float*)(GAS const float*)g(13); }
    __device__ __forceinline__ const float* final_g() const { return (const float*)(GAS const float*)g(15); }
    __device__ __forceinline__ float* out() const { return (float*)(GAS float*)g(16); }
    __device__ __forceinline__ unsigned char* ws() const { return (unsigned char*)(GAS unsigned char*)g(17); }
};


#define XB_TMO      128
#define XB_XCNT(j)  (256  + 64 * (j))
#define XB_XSUB(j)  (1280 + 64 * (j))
#define XB_XGEN(j)  (2304 + 64 * (j))
#define XB_TOP      3328
#define XB_TOPGEN   3392
#define XCD_BAR_WORDS 3456
#define XB_SPIN_CAP (1u << 18)
__device__ __forceinline__ unsigned xb_ld(unsigned* p)              { return __hip_atomic_load(p, __ATOMIC_RELAXED, __HIP_MEMORY_SCOPE_AGENT); }
__device__ __forceinline__ unsigned xb_add(unsigned* p, unsigned v) { return __hip_atomic_fetch_add(p, v, __ATOMIC_RELAXED, __HIP_MEMORY_SCOPE_AGENT); }
__device__ __forceinline__ unsigned xb_xcc_id() { return (unsigned)__builtin_amdgcn_s_getreg((3 << 11) | 20) & 0xFu; }
#define XB_SPIN(cond, bar) do { unsigned _sp = 0; while (cond) { __builtin_amdgcn_s_sleep(1); \
    if ((++_sp & 255u) == 0u) { if (xb_ld(&(bar)[XB_TMO])) break; if (_sp > XB_SPIN_CAP) { atomicAdd(&(bar)[XB_TMO], 1u); break; } } } } while (0)
__device__ __forceinline__ void xcd_barrier_post(unsigned* bar) { if (threadIdx.x == 0) (void)xb_add(&bar[XB_XCNT(xb_xcc_id())], 1u); }
__device__ __forceinline__ void xcd_barrier_complete(unsigned* bar, unsigned x, unsigned& nloc, unsigned& nx) {
    const unsigned G = gridDim.x * gridDim.y * gridDim.z;
    unsigned sum, cnt, mine, sp = 0u;
    for (;;) {
        sum = 0u; cnt = 0u; mine = 0u;
#pragma unroll
        for (unsigned j = 0; j < 16; ++j) { const unsigned c = xb_ld(&bar[XB_XCNT(j)]); sum += c; cnt += (c > 0u) ? 1u : 0u; mine = (j == x) ? c : mine; }
        if (sum == G) break;
        __builtin_amdgcn_s_sleep(1);
        if ((++sp & 255u) == 0u) { if (xb_ld(&bar[XB_TMO])) break; if (sp > XB_SPIN_CAP) { atomicAdd(&bar[XB_TMO], 1u); break; } }
    }
    nloc = mine > 0u ? mine : 1u; nx = cnt > 0u ? cnt : 1u;
}
__device__ __forceinline__ void xcd_barrier(unsigned* bar, volatile LAS unsigned* st) {
    asm volatile("s_waitcnt vmcnt(0)" ::: "memory");
    __syncthreads();
    if (threadIdx.x == 0) {
        const unsigned x = xb_xcc_id();
        __builtin_amdgcn_s_waitcnt(0);
        unsigned nloc = st[0], nx = st[1];
        if (nloc == 0u) { xcd_barrier_complete(bar, x, nloc, nx); st[0] = nloc; st[1] = nx; }
        const unsigned old = xb_add(&bar[XB_XSUB(x)], 1u);
        const unsigned gen = old / nloc;
        if (old + 1u == (gen + 1u) * nloc) {
            __builtin_amdgcn_fence(__ATOMIC_RELEASE, "agent");
            asm volatile("s_waitcnt vmcnt(0)" ::: "memory");
            const unsigned og = xb_add(&bar[XB_TOP], 1u);
            const unsigned tg = og / nx;
            if (og + 1u == (tg + 1u) * nx) xb_add(&bar[XB_TOPGEN], 1u);
            else XB_SPIN(xb_ld(&bar[XB_TOPGEN]) == tg, bar);
            __builtin_amdgcn_fence(__ATOMIC_ACQUIRE, "agent");
            xb_add(&bar[XB_XGEN(x)], 1u);
            asm volatile("s_waitcnt vmcnt(0)" ::: "memory");
        } else {
            XB_SPIN(xb_ld(&bar[XB_XGEN(x)]) == gen, bar);
            __builtin_amdgcn_fence(__ATOMIC_ACQUIRE, "agent");
            asm volatile("s_waitcnt vmcnt(0)" ::: "memory");
        }
    }
    __syncthreads();
}

__device__ __forceinline__ float bf2f(unsigned short b) { return __uint_as_float(((unsigned)b) << 16); }
__device__ __forceinline__ float bflo(unsigned w) { return __uint_as_float(w << 16); }
__device__ __forceinline__ float bfhi(unsigned w) { return __uint_as_float(w & 0xFFFF0000u); }
__device__ __forceinline__ unsigned short f2bf(float f) { unsigned u = __float_as_uint(f); u += 0x7FFFu + ((u >> 16) & 1u); return (unsigned short)(u >> 16); }
__device__ __forceinline__ unsigned pk2(float lo, float hi) { unsigned r; asm("v_cvt_pk_bf16_f32 %0, %1, %2" : "=v"(r) : "v"(lo), "v"(hi)); return r; }
__device__ __forceinline__ float fast_sigmoid(float x) { return __builtin_amdgcn_rcpf(1.0f + __builtin_amdgcn_exp2f(-1.4426950408889634f * x)); }
__device__ __forceinline__ float silu_f(float x) { return x * fast_sigmoid(x); }
__device__ __forceinline__ float gelu_tanh_f(float x) { const float u = 0.7978845608028654f * (x + 0.044715f * x * x * x); return x * fast_sigmoid(2.0f * u); }
__device__ __forceinline__ float ror1(float v) { return __builtin_bit_cast(float, __builtin_amdgcn_mov_dpp(__builtin_bit_cast(int, v), 0x121, 0xf, 0xf, true)); }
__device__ __forceinline__ float ror2(float v) { return __builtin_bit_cast(float, __builtin_amdgcn_mov_dpp(__builtin_bit_cast(int, v), 0x122, 0xf, 0xf, true)); }
__device__ __forceinline__ f32x2 silu2(f32x2 c) { const f32x2 t = c * (-1.4426950408889634f); f32x2 e; e.x = __builtin_amdgcn_exp2f(t.x); e.y = __builtin_amdgcn_exp2f(t.y); const f32x2 d = e + 1.0f; f32x2 r; r.x = __builtin_amdgcn_rcpf(d.x); r.y = __builtin_amdgcn_rcpf(d.y); return c * r; }
__device__ __forceinline__ float log2_gamma(int h) { return log1pf(-exp2f(-5.0f - (float)h)) * 1.4426950408889634f; }
__device__ __forceinline__ float rstd_from_ss(const bf16_t* SS, int row) {
    const u32x4* p = (const u32x4*)(SS + (size_t)row * 16);
    const u32x4 a = p[0], b = p[1];
    const float s = ((bflo(a.x) + bfhi(a.x)) + (bflo(a.y) + bfhi(a.y))) + ((bflo(a.z) + bfhi(a.z)) + (bflo(a.w) + bfhi(a.w)))
                  + ((bflo(b.x) + bfhi(b.x)) + (bflo(b.y) + bfhi(b.y))) + ((bflo(b.z) + bfhi(b.z)) + (bflo(b.w) + bfhi(b.w)));
    return rsqrtf(s * (1.0f / 1024.0f) + 1e-6f);
}
__device__ __forceinline__ float rstd_row_lds(const LAS unsigned char* ssl, int rt, int fq) {
    const u32x2 a = *(const LAS u32x2*)(ssl + rt * 32 + fq * 8);
    float s = (bflo(a.x) + bfhi(a.x)) + (bflo(a.y) + bfhi(a.y));
    s += __shfl_xor(s, 16); s += __shfl_xor(s, 32);
    return rsqrtf(s * (1.0f / 1024.0f) + 1e-6f);
}
__device__ __forceinline__ void prefetch_ss(const bf16_t* SS, LAS unsigned char* ldx, int pm, int par, int wid, int lane) {
    __builtin_amdgcn_global_load_lds((const unsigned*)((const char*)SS + (size_t)pm * 8192 + wid * 1024 + lane * 16), (LAS unsigned*)(ldx + LDSX_SS + par * 8192 + wid * 1024), 16, 0, 0);
}

namespace pg8 {
constexpr int BM = 256, BK = 64, HALF = 128, HTB = HALF * BK * 2, STAGE_BYTES = 8 * HTB, NXCD = 8, WGM = 8;
__host__ __device__ __forceinline__ int lds_byte(int r, int c) { const int st = (r >> 4) * 2 + (c >> 5), rr = r & 15, cc = c & 31, ob = rr * 64 + cc * 2; return st * 1024 + (ob ^ (((ob >> 9) & 1) << 5)); }
__host__ __device__ __forceinline__ void stage_rc(int b, int& R, int& C) { const int st = b / 1024, sb = b % 1024, swz = sb ^ (((sb >> 9) & 1) << 5); R = (st >> 1) * 16 + swz / 64; C = (st & 1) * 32 + (swz % 64) / 2; }
__host__ __device__ __forceinline__ int perm32(int rho) { const int n = rho >> 4, i = rho & 15; return 8 * (i >> 2) + 4 * n + (i & 3); }
struct Unit { int pm, pn; };
struct Gemm { const bf16_t* A; const bf16_t* Bt; int M, N, K; };
struct StaticOrder {
    int nM, nN, nwg, G, c, rev;
    __device__ void init(int M, int N, int G_, int c_, int rev_ = 0) { nM = M / BM; nN = N / BM; nwg = nM * nN; G = G_; c = c_; rev = rev_; }
    __device__ bool next(int i, Unit& u) const {
        const long L = (long)i * G + c; if (L >= nwg) return false;
        int wgid = (int)L; { const int q = nwg / NXCD, r = nwg % NXCD, xcd = wgid % NXCD, off = wgid / NXCD; wgid = (xcd < r ? xcd * (q + 1) : r * (q + 1) + (xcd - r) * q) + off; }
        const int nig = WGM * nN, gid = wgid / nig, fm = gid * WGM, gsz = (nM - fm) < WGM ? (nM - fm) : WGM;
        u.pm = fm + ((wgid % nig) % gsz); u.pn = (wgid % nig) / gsz; if (rev) u.pm = nM - 1 - u.pm; return true;
    }
};

template <class Epi, class Sched>
__device__ __forceinline__ void gemm_phase(LAS unsigned char* lds, const Gemm g, const Sched& S, const Epi& E) {
    LAS unsigned char* ldx = lds + LDS_X;
    int tid = threadIdx.x; asm volatile("" : "+v"(tid));
    const int wid = __builtin_amdgcn_readfirstlane(tid >> 6), lane = tid & 63, wr = wid >> 2, wc = wid & 3, fr = lane & 15, fq = lane >> 4;
    const int K = g.K, nt = K / BK;
    unsigned voffA[2], voffB[2];
#pragma unroll
    for (int i = 0; i < 2; ++i) { int R, C; stage_rc(tid * 16 + i * 8192, R, C); const int Rb = Epi::PERM ? ((R & ~31) + perm32(R & 31)) : R;
        voffA[i] = (unsigned)(R * K + C) * 2u; voffB[i] = (unsigned)(Rb * K + C) * 2u; }
    const size_t kstep = (size_t)(BK * 2);
    const size_t hstep = (size_t)HALF * K * 2;
    const size_t tstep = 2 * hstep;
    const unsigned ldsw = (unsigned)wid * 1024u;
    const int aoff = lds_byte(wr * 64 + fr, fq * 8), boff = lds_byte(wc * 32 + fr, fq * 8);
#define PG8_SA(b, h) (((b) * 2 + (h)) * HTB)
#define PG8_SB(b, h) ((4 + (b) * 2 + (h)) * HTB)
#define PG8_STAGE(bufoff, gbase, voff) do { _Pragma("unroll") for (int _i = 0; _i < 2; ++_i) \
        __builtin_amdgcn_global_load_lds((const unsigned*)((const char*)(gbase) + (voff)[_i]), (LAS unsigned*)(lds + (bufoff) + ldsw + _i * 8192), 16, 0, 0); } while (0)
#define PG8_LDA(dst, b, h) do { _Pragma("unroll") for (int m = 0; m < 4; ++m) _Pragma("unroll") for (int k = 0; k < 2; ++k) dst[m][k] = *(const LAS bf16x8*)(lds + PG8_SA(b, h) + aoff + m * 2048 + k * 1024); } while (0)
#define PG8_LDB(dst, b, h) do { _Pragma("unroll") for (int n = 0; n < 2; ++n) _Pragma("unroll") for (int k = 0; k < 2; ++k) dst[n][k] = *(const LAS bf16x8*)(lds + PG8_SB(b, h) + boff + n * 2048 + k * 1024); } while (0)
#define PG8_MMA(ai, bj, At, Bt) do { __builtin_amdgcn_s_setprio(1); _Pragma("unroll") for (int m = 0; m < 4; ++m) _Pragma("unroll") for (int n = 0; n < 2; ++n) _Pragma("unroll") for (int k = 0; k < 2; ++k) \
        acc[ai][bj][m][n] = __builtin_amdgcn_mfma_f32_16x16x32_bf16(Bt[n][k], At[m][k], acc[ai][bj][m][n], 0, 0, 0); __builtin_amdgcn_s_setprio(0); } while (0)
#define PG8_WAIT_V(n) asm volatile("s_waitcnt vmcnt(" #n ")" ::: "memory")
#define PG8_WAIT_L(n) asm volatile("s_waitcnt lgkmcnt(" #n ")" ::: "memory")
#define PG8_BAR __builtin_amdgcn_s_barrier()
#define PG8_SCHED __builtin_amdgcn_sched_barrier(0)
    Unit cur, nxt; int ui = 0;
    if (!S.next(0, cur)) return;
    f32x4 acc[2][2][4][2];
#pragma unroll
    for (int a = 0; a < 2; ++a)
#pragma unroll
        for (int b = 0; b < 2; ++b)
#pragma unroll
            for (int m = 0; m < 4; ++m)
#pragma unroll
                for (int n = 0; n < 2; ++n) acc[a][b][m][n] = (f32x4){0.f, 0.f, 0.f, 0.f};
    bf16x8 At[4][2], B0[2][2], B1[2][2];
    const char* cA = (const char*)g.A + (size_t)cur.pm * tstep; const char* cB = (const char*)g.Bt + (size_t)cur.pn * tstep;
    E.prefetch(ldx, cur, 0, wid, lane);
    PG8_STAGE(PG8_SB(0, 0), cB, voffB); PG8_STAGE(PG8_SA(0, 0), cA, voffA); PG8_STAGE(PG8_SB(0, 1), cB + hstep, voffB); PG8_STAGE(PG8_SA(0, 1), cA + hstep, voffA);
    if (wr == 1) PG8_BAR;
    PG8_WAIT_V(4); PG8_BAR;
    PG8_STAGE(PG8_SB(1, 0), cB + kstep, voffB); PG8_STAGE(PG8_SA(1, 0), cA + kstep, voffA); PG8_STAGE(PG8_SB(1, 1), cB + hstep + kstep, voffB); PG8_STAGE(PG8_SA(1, 1), cA + hstep + kstep, voffA);
    PG8_WAIT_V(8); PG8_BAR;
    for (;;) {
        const bool has_next = S.next(ui + 1, nxt);
        const char* nA = has_next ? (const char*)g.A + (size_t)nxt.pm * tstep : cA; const char* nB = has_next ? (const char*)g.Bt + (size_t)nxt.pn * tstep : cB;
        for (int t = 0; t < nt; t += 2) {
            const bool last = (t == nt - 2);
            const char* a1 = cA + (size_t)(t + 1) * kstep;
            const char* a2 = last ? nA : cA + (size_t)(t + 2) * kstep; const char* b2 = last ? nB : cB + (size_t)(t + 2) * kstep;
            const char* a3 = a2 + kstep; const char* b3 = b2 + kstep;
            PG8_LDB(B0, 0, 0); PG8_SCHED; PG8_LDA(At, 0, 0);
            PG8_WAIT_L(8); PG8_BAR; PG8_WAIT_L(0); PG8_MMA(0, 0, At, B0); PG8_BAR; PG8_SCHED;
            PG8_LDB(B1, 0, 1); PG8_STAGE(PG8_SB(0, 0), b2, voffB);
            PG8_BAR; PG8_WAIT_L(0); PG8_MMA(0, 1, At, B1); PG8_BAR;
            PG8_LDA(At, 0, 1); PG8_STAGE(PG8_SA(0, 0), a2, voffA);
            PG8_BAR; PG8_WAIT_L(0); PG8_MMA(1, 0, At, B0); PG8_BAR; PG8_SCHED;
            PG8_STAGE(PG8_SB(0, 1), b2 + hstep, voffB);
            { const int pre_ = __builtin_amdgcn_readfirstlane((t == 0 && ui > 0) ? 1 : 0);
              asm volatile("s_cmp_eq_u32 %0, 0\n\ts_cbranch_scc1 2\n\ts_waitcnt vmcnt(22)\n\ts_branch 1\n\ts_waitcnt vmcnt(6)" :: "s"(pre_) : "memory", "scc"); }
            PG8_BAR; PG8_MMA(1, 1, At, B1); PG8_BAR;
            PG8_LDB(B0, 1, 0); PG8_SCHED; PG8_LDA(At, 1, 0); PG8_STAGE(PG8_SA(0, 1), a2 + hstep, voffA);
            PG8_WAIT_L(8); PG8_BAR; PG8_WAIT_L(0); PG8_MMA(0, 0, At, B0); PG8_BAR; PG8_SCHED;
            PG8_LDB(B1, 1, 1); PG8_STAGE(PG8_SB(1, 0), b3, voffB);
            PG8_BAR; PG8_WAIT_L(0); PG8_MMA(0, 1, At, B1); PG8_BAR;
            PG8_LDA(At, 1, 1); PG8_STAGE(PG8_SA(1, 0), a3, voffA);
            PG8_BAR; PG8_WAIT_L(0); PG8_MMA(1, 0, At, B0); PG8_BAR; PG8_SCHED;
            PG8_STAGE(PG8_SB(1, 1), b3 + hstep, voffB);
            PG8_WAIT_V(6); PG8_BAR; PG8_MMA(1, 1, At, B1); PG8_BAR;
            PG8_STAGE(PG8_SA(1, 1), a3 + hstep, voffA);
        }
        E(acc, cur, wr, wc, fr, fq, ldx, ui & 1);
        if (!has_next) break;
#pragma unroll
        for (int a = 0; a < 2; ++a)
#pragma unroll
            for (int b = 0; b < 2; ++b)
#pragma unroll
                for (int m = 0; m < 4; ++m)
#pragma unroll
                    for (int n = 0; n < 2; ++n) acc[a][b][m][n] = (f32x4){0.f, 0.f, 0.f, 0.f};
        cur = nxt; cA = nA; cB = nB; ++ui;
        E.prefetch(ldx, cur, ui & 1, wid, lane);
    }
    PG8_WAIT_V(0);
    if (wr == 0) PG8_BAR;
    PG8_BAR;
#undef PG8_SA
#undef PG8_SB
#undef PG8_STAGE
#undef PG8_LDA
#undef PG8_LDB
#undef PG8_MMA
#undef PG8_WAIT_V
#undef PG8_WAIT_L
#undef PG8_BAR
#undef PG8_SCHED
}
}


struct EpiProj {
    static constexpr bool PERM = true;
    bf16_t* O; const bf16_t* SS;
    __device__ __forceinline__ void prefetch(LAS unsigned char* ldx, const pg8::Unit& u, int par, int wid, int lane) const { prefetch_ss(SS, ldx, u.pm, par, wid, lane); }
    __device__ __forceinline__ void operator()(const f32x4 (&acc)[2][2][4][2], const pg8::Unit& u, int wr, int wc, int fr_, int fq_, LAS unsigned char* ldx, int par) const {
        int ln_ = fr_ | (fq_ << 4); asm volatile("" : "+v"(ln_)); const int fr = ln_ & 15, fq = ln_ >> 4;
        const int pn = u.pn;
        const int mode = (pn < 2) ? 1 : (pn == 2) ? 0 : (pn < 5) ? 2 : (pn < 7) ? 3 : (pn < 9) ? 0 : 4;
        const int row0 = u.pm * 256 + wr * 64 + fr;
        f32x2 invr[2];
#pragma unroll
        for (int j = 0; j < 4; ++j) { const float dp = (float)(16 * (wc & 1) + 4 * fq + j); const float v = exp2f(-dp * 0.41524101186092034f) * 0.15915494309189535f; if (j & 1) invr[j >> 1].y = v; else invr[j >> 1].x = v; }
#pragma unroll
        for (int ai = 0; ai < 2; ++ai)
#pragma unroll
            for (int m = 0; m < 4; ++m) {
                const int row = row0 + ai * 128 + m * 16;
                const float rs = rstd_row_lds(ldx + LDSX_SS + par * 8192, ai * 128 + wr * 64 + m * 16 + fr, fq);
                bf16_t* rowp = O + (size_t)row * NIN + pn * 256 + wc * 32 + fq * 8;
                if (mode == 2 || mode == 3) {
                    const float pos = (float)(row & (SEQL - 1));
                    const float sc = ((mode == 2) ? 0.125f : 1.0f) * rs;
                    f32x2 cs[2], sn[2];
#pragma unroll
                    for (int jp = 0; jp < 2; ++jp) {
                        f32x2 rev = invr[jp] * pos; rev.x -= floorf(rev.x); rev.y -= floorf(rev.y);
                        cs[jp].x = __builtin_amdgcn_cosf(rev.x) * sc; cs[jp].y = __builtin_amdgcn_cosf(rev.y) * sc;
                        sn[jp].x = __builtin_amdgcn_sinf(rev.x) * sc; sn[jp].y = __builtin_amdgcn_sinf(rev.y) * sc;
                    }
#pragma unroll
                    for (int bj = 0; bj < 2; ++bj) {
                        const f32x4 x1 = acc[ai][bj][m][0], x2 = acc[ai][bj][m][1];
                        const f32x2 a0 = x1.xy * cs[0] - x2.xy * sn[0], a1 = x1.zw * cs[1] - x2.zw * sn[1];
                        const f32x2 b0 = x2.xy * cs[0] + x1.xy * sn[0], b1 = x2.zw * cs[1] + x1.zw * sn[1];
                        u32x4 w; w.x = pk2(a0.x, a0.y); w.y = pk2(a1.x, a1.y); w.z = pk2(b0.x, b0.y); w.w = pk2(b1.x, b1.y);
                        *(u32x4*)(rowp + bj * 128) = w;
                    }
                } else {
#pragma unroll
                    for (int bj = 0; bj < 2; ++bj) {
                        f32x2 v[4];
                        v[0] = acc[ai][bj][m][0].xy * rs; v[1] = acc[ai][bj][m][0].zw * rs; v[2] = acc[ai][bj][m][1].xy * rs; v[3] = acc[ai][bj][m][1].zw * rs;
                        if (mode == 1) {
#pragma unroll
                            for (int i = 0; i < 4; ++i) {
                                const f32x2 x = v[i], t = x * x;
                                const f32x2 ar = x * (t * (-2.3022082f * 0.044715f) + (-2.3022082f));
                                f32x2 e; e.x = __builtin_amdgcn_exp2f(ar.x); e.y = __builtin_amdgcn_exp2f(ar.y);
                                const f32x2 d = e + 1.0f; f32x2 r; r.x = __builtin_amdgcn_rcpf(d.x); r.y = __builtin_amdgcn_rcpf(d.y);
                                v[i] = x * r;
                            }
                        } else if (mode == 4) {
#pragma unroll
                            for (int i = 0; i < 4; ++i) v[i] = silu2(v[i]);
                        }
                        u32x4 w; w.x = pk2(v[0].x, v[0].y); w.y = pk2(v[1].x, v[1].y); w.z = pk2(v[2].x, v[2].y); w.w = pk2(v[3].x, v[3].y);
                        *(u32x4*)(rowp + bj * 128) = w;
                    }
                }
            }
    }
};

struct EpiRes {
    static constexpr bool PERM = true;
    bf16_t* XB; bf16_t* SSo;
    __device__ __forceinline__ void prefetch(LAS unsigned char*, const pg8::Unit&, int, int, int) const {}
    __device__ __forceinline__ void operator()(const f32x4 (&acc)[2][2][4][2], const pg8::Unit& u, int wr, int wc, int fr_, int fq_, LAS unsigned char*, int) const {
        int ln_ = fr_ | (fq_ << 4); asm volatile("" : "+v"(ln_)); const int fr = ln_ & 15, fq = ln_ >> 4;
        const int row0 = u.pm * 256 + wr * 64 + fr, col0 = u.pn * 256 + wc * 32 + fq * 8;
        u32x4 res[2][4][2];
#pragma unroll
        for (int ai = 0; ai < 2; ++ai)
#pragma unroll
            for (int m = 0; m < 4; ++m)
#pragma unroll
                for (int bj = 0; bj < 2; ++bj) res[ai][m][bj] = *(const u32x4*)(XB + (unsigned)(row0 + ai * 128 + m * 16) * (unsigned)DM + col0 + bj * 128);
#pragma unroll
        for (int ai = 0; ai < 2; ++ai)
#pragma unroll
            for (int m = 0; m < 4; ++m) {
                const int row = row0 + ai * 128 + m * 16;
                float ssq = 0.f;
#pragma unroll
                for (int bj = 0; bj < 2; ++bj) {
                    const unsigned idx = (unsigned)row * (unsigned)DM + col0 + bj * 128;
                    const u32x4 r = res[ai][m][bj];
                    const f32x4 a0 = acc[ai][bj][m][0], a1 = acc[ai][bj][m][1];
                    const float o0 = a0[0] + bflo(r.x), o1 = a0[1] + bfhi(r.x), o2 = a0[2] + bflo(r.y), o3 = a0[3] + bfhi(r.y);
                    const float o4 = a1[0] + bflo(r.z), o5 = a1[1] + bfhi(r.z), o6 = a1[2] + bflo(r.w), o7 = a1[3] + bfhi(r.w);
                    u32x4 w; w.x = pk2(o0, o1); w.y = pk2(o2, o3); w.z = pk2(o4, o5); w.w = pk2(o6, o7);
                    *(u32x4*)(XB + idx) = w;
                    ssq += (o0 * o0 + o1 * o1) + (o2 * o2 + o3 * o3) + (o4 * o4 + o5 * o5) + (o6 * o6 + o7 * o7);
                }
                ssq += __shfl_xor(ssq, 16);
                ssq += __shfl_xor(ssq, 32);
                if (fq == 0) SSo[(size_t)row * 16 + u.pn * 4 + wc] = f2bf(ssq);
            }
    }
};

struct EpiUp {
    static constexpr bool PERM = true;
    unsigned char* wsb; const float* cw; const float* cb;
    __device__ __forceinline__ void prefetch(LAS unsigned char* ldx, const pg8::Unit& u, int par, int wid, int lane) const {
        prefetch_ss((const bf16_t*)(wsb + WS_SS), ldx, u.pm, par, wid, lane);
        const int pr = lane >> 4, half = (lane >> 3) & 1, c4 = (lane & 7) * 4;
        const float* src = (pr < 3 ? cw + pr * NUP : cb) + half * DFF + u.pn * 128 + (wid & 3) * 32 + c4;
        __builtin_amdgcn_global_load_lds((const unsigned*)src, (LAS unsigned*)(ldx + LDSX_W + wid * 1024), 16, 0, 0);
    }
    __device__ __forceinline__ void operator()(f32x4 (&acc)[2][2][4][2], const pg8::Unit& u, int wr, int wc, int fr_, int fq_, LAS unsigned char* ldx, int par) const {
        int ln_ = fr_ | (fq_ << 4); asm volatile("" : "+v"(ln_)); const int fr = ln_ & 15, fq = ln_ >> 4;
        const int row0 = u.pm * 256 + wr * 64 + fr;
        const int ct = wc * 32 + fq * 8;
        bf16_t* ACT = (bf16_t*)(wsb + WS_PROJ); bf16_t* HALO = (bf16_t*)(wsb + WS_HALO);
        LAS float* wl = (LAS float*)(ldx + LDSX_W + (wr * 4 + wc) * 1024);
        {
            const LAS unsigned char* ssl = ldx + LDSX_SS + par * 8192;
#pragma unroll
            for (int ai = 0; ai < 2; ++ai)
#pragma unroll
                for (int m = 0; m < 4; ++m) {
                    const float r = rstd_row_lds(ssl, ai * 128 + wr * 64 + m * 16 + fr, fq);
#pragma unroll
                    for (int bj = 0; bj < 2; ++bj)
#pragma unroll
                        for (int n = 0; n < 2; ++n) acc[ai][bj][m][n] = acc[ai][bj][m][n] * r;
                }
        }
        if (fr < 2 || fr >= 14) {
            const int slot = (fr < 2) ? fr : fr - 12;
#pragma unroll
            for (int ai = 0; ai < 2; ++ai) {
                const int strip = u.pm * 4 + ai * 2 + wr;
                bf16_t* hp = HALO + ((size_t)strip * 4 + slot) * NUP + u.pn * 256 + ct;
#pragma unroll
                for (int bj = 0; bj < 2; ++bj) {
                    const f32x4 a0 = (fr < 2) ? acc[ai][bj][0][0] : acc[ai][bj][3][0];
                    const f32x4 a1 = (fr < 2) ? acc[ai][bj][0][1] : acc[ai][bj][3][1];
                    u32x4 w; w.x = pk2(a0[0], a0[1]); w.y = pk2(a0[2], a0[3]); w.z = pk2(a1[0], a1[1]); w.w = pk2(a1[2], a1[3]);
                    *(u32x4*)(hp + bj * 128) = w;
                }
            }
        }
        __builtin_amdgcn_sched_barrier(0);
        const bool ge1 = fr >= 1, ge2 = fr >= 2;
#pragma unroll
        for (int n = 0; n < 2; ++n) {
            const unsigned colg = u.pn * 128 + ct + n * 4;
            const int lc = fq * 8 + n * 4;
#pragma unroll
            for (int ai = 0; ai < 2; ++ai) {
                f32x2 sg[4][2];
                {
                    const f32x4 w0 = *(const LAS f32x4*)(wl + 0 * 64 + lc), w1 = *(const LAS f32x4*)(wl + 1 * 64 + lc), w2 = *(const LAS f32x4*)(wl + 2 * 64 + lc), wb = *(const LAS f32x4*)(wl + 3 * 64 + lc);
#pragma unroll
                    for (int jp = 0; jp < 2; ++jp) {
                        const f32x2 a0 = jp ? w0.zw : w0.xy, a1 = jp ? w1.zw : w1.xy, a2 = jp ? w2.zw : w2.xy, ab = jp ? wb.zw : wb.xy;
                        f32x2 r1 = {0.f, 0.f}, r2 = {0.f, 0.f};
#pragma unroll
                        for (int m = 0; m < 4; ++m) {
                            const f32x2 x = jp ? acc[ai][0][m][n].zw : acc[ai][0][m][n].xy;
                            f32x2 n1, n2, p1, p2;
                            n1.x = ror1(x.x); n1.y = ror1(x.y); n2.x = ror2(x.x); n2.y = ror2(x.y);
                            p1.x = ge1 ? n1.x : r1.x; p1.y = ge1 ? n1.y : r1.y; p2.x = ge2 ? n2.x : r2.x; p2.y = ge2 ? n2.y : r2.y;
                            sg[m][jp] = silu2(ab + a0 * p2 + a1 * p1 + a2 * x);
                            r1 = n1; r2 = n2;
                        }
                    }
                }
                {
                    const f32x4 w0 = *(const LAS f32x4*)(wl + 0 * 64 + 32 + lc), w1 = *(const LAS f32x4*)(wl + 1 * 64 + 32 + lc), w2 = *(const LAS f32x4*)(wl + 2 * 64 + 32 + lc), wb = *(const LAS f32x4*)(wl + 3 * 64 + 32 + lc);
                    unsigned ow[4][2];
#pragma unroll
                    for (int jp = 0; jp < 2; ++jp) {
                        const f32x2 a0 = jp ? w0.zw : w0.xy, a1 = jp ? w1.zw : w1.xy, a2 = jp ? w2.zw : w2.xy, ab = jp ? wb.zw : wb.xy;
                        f32x2 r1 = {0.f, 0.f}, r2 = {0.f, 0.f};
#pragma unroll
                        for (int m = 0; m < 4; ++m) {
                            const f32x2 x = jp ? acc[ai][1][m][n].zw : acc[ai][1][m][n].xy;
                            f32x2 n1, n2, p1, p2;
                            n1.x = ror1(x.x); n1.y = ror1(x.y); n2.x = ror2(x.x); n2.y = ror2(x.y);
                            p1.x = ge1 ? n1.x : r1.x; p1.y = ge1 ? n1.y : r1.y; p2.x = ge2 ? n2.x : r2.x; p2.y = ge2 ? n2.y : r2.y;
                            const f32x2 o = sg[m][jp] * (ab + a0 * p2 + a1 * p1 + a2 * x);
                            ow[m][jp] = pk2(o.x, o.y);
                            r1 = n1; r2 = n2;
                        }
                    }
#pragma unroll
                    for (int m = 0; m < 4; ++m) {
                        u32x2 w; w.x = ow[m][0]; w.y = ow[m][1];
                        const unsigned off = (unsigned)(row0 + ai * 128 + m * 16) * (unsigned)DFF + colg;
                        *(u32x2*)(ACT + off) = w;
                    }
                }
            }
        }
    }
};

__device__ __forceinline__ int win_cmap(int r) {
    if (r >= PC_Q && r < PC_VV) { const int p = r & 63, w = p >> 5, q = (p >> 3) & 3, n = (p >> 2) & 1, j = p & 3; return (r & ~63) + 16 * w + 4 * q + j + 32 * n; }
    return r;
}
__device__ __forceinline__ int wup_cmap(int r) { const int pn = r >> 8, ct = r & 255; return (ct < 128) ? pn * 128 + ct : DFF + pn * 128 + (ct - 128); }

__device__ __forceinline__ void wconv_tile(float* T, const float* src, int N, int K, bf16_t* dst, int kt, int rt, int mapmode, const float* gs, int tid) {
    const int rr = tid & 255, k0 = kt * 64, kh = tid >> 8;
    const int r = rt * 256 + rr;
    const int c = (mapmode == 1) ? win_cmap(r) : (mapmode == 2) ? wup_cmap(r) : r;
    float v[32];
#pragma unroll
    for (int i = 0; i < 32; ++i) v[i] = src[(size_t)(k0 + i * 2 + kh) * N + c];
    if (gs) {
#pragma unroll
        for (int i = 0; i < 32; ++i) v[i] *= gs[k0 + i * 2 + kh];
    }
#pragma unroll
    for (int i = 0; i < 32; ++i) T[(i * 2 + kh) * 257 + rr] = v[i];
    __syncthreads();
#pragma unroll
    for (int ps = 0; ps < 4; ++ps) {
        const int r2 = (tid >> 3) + ps * 64, kc = tid & 7;
        float f[8];
#pragma unroll
        for (int i = 0; i < 8; ++i) f[i] = T[(kc * 8 + i) * 257 + r2];
        u32x4 w; w.x = pk2(f[0], f[1]); w.y = pk2(f[2], f[3]); w.z = pk2(f[4], f[5]); w.w = pk2(f[6], f[7]);
        *(u32x4*)(dst + (size_t)(rt * 256 + r2) * K + k0 + kc * 8) = w;
    }
    __syncthreads();
}

__device__ __forceinline__ void wconv_job(float* T, unsigned char* ws, const float* w_in, const float* w_out, const float* w_up, const float* w_down, const float* n1g, const float* n2g, int l, int t, int tid) {
    if (t < 176) { wconv_tile(T, w_in + (size_t)l * DM * NIN, NIN, DM, (bf16_t*)(ws + WS_WIN) + (size_t)l * NIN * DM, t % 16, t / 16, 1, n1g + l * DM, tid); }
    else if (t < 240) { t -= 176; wconv_tile(T, w_out + (size_t)l * DM * DM, DM, DM, (bf16_t*)(ws + WS_WOUT) + (size_t)l * DM * DM, t % 16, t / 16, 0, nullptr, tid); }
    else if (t < 592) { t -= 240; wconv_tile(T, w_up + (size_t)l * DM * NUP, NUP, DM, (bf16_t*)(ws + WS_WUP) + (size_t)l * NUP * DM, t % 16, t / 16, 2, n2g + l * DM, tid); }
    else { t -= 592; wconv_tile(T, w_down + (size_t)l * DFF * DM, DM, DFF, (bf16_t*)(ws + WS_WDN) + (size_t)l * DM * DFF, t % 44, t / 44, 0, nullptr, tid); }
}

__device__ __forceinline__ void phase_prologue(const Params& p, unsigned char* lds) {
    unsigned char* ws = p.ws;
    float* T = (float*)lds;
    int tid = threadIdx.x; asm volatile("" : "+v"(tid));
    const int G = gridDim.x, bid = blockIdx.x;
    {
        const int nl = (G == 256) ? 1 : NLAYER;
        for (int job = bid; job < nl * 768; job += G) wconv_job(T, ws, p.w_in, p.w_out, p.w_up, p.w_down, p.norm1_g, p.norm2_g, job / 768, job % 768, tid);
    }
    {
        bf16_t* AWS = (bf16_t*)(ws + WS_AWS); bf16_t* BWT = (bf16_t*)(ws + WS_BWT);
        for (int i = bid * NTHR + tid; i < NLAYER * 4 * 128 * 128; i += G * NTHR) {
            const int s = i & 127, t = (i >> 7) & 127;
            const float v = ((t >> 6) >= (s >> 6)) ? p.a_ws[i] : 0.f;
            AWS[i] = f2bf(v);
        }
        for (int i = bid * NTHR + tid; i < NLAYER * 4 * 64 * 64; i += G * NTHR) {
            const int c = i & 63, d = (i >> 6) & 63, lg = i >> 12;
            BWT[i] = f2bf(p.b_w[(size_t)lg * 4096 + c * 64 + d]);
        }
    }
    {
        bf16_t* XB = (bf16_t*)(ws + WS_XB); bf16_t* SS = (bf16_t*)(ws + WS_SS);
        const int wave = tid >> 6, lane = tid & 63;
        const int rstride = G * 8;
        for (int row0 = bid * 8 + wave; row0 < MTOK; row0 += 8 * rstride) {
            f32x4 v[8][4];
#pragma unroll
            for (int r = 0; r < 8; ++r) {
                const int row = row0 + r * rstride;
                if (row < MTOK) {
#pragma unroll
                    for (int i = 0; i < 2; ++i) { v[r][2 * i] = *(const f32x4*)(p.x + (size_t)row * DM + i * 512 + lane * 8); v[r][2 * i + 1] = *(const f32x4*)(p.x + (size_t)row * DM + i * 512 + lane * 8 + 4); }
                }
            }
#pragma unroll
            for (int r = 0; r < 8; ++r) {
                const int row = row0 + r * rstride;
                if (row < MTOK) {
                    float ss = 0.f;
#pragma unroll
                    for (int i = 0; i < 2; ++i) {
                        const f32x4 q0 = v[r][2 * i], q1 = v[r][2 * i + 1];
                        ss += (q0[0] * q0[0] + q0[1] * q0[1]) + (q0[2] * q0[2] + q0[3] * q0[3]) + (q1[0] * q1[0] + q1[1] * q1[1]) + (q1[2] * q1[2] + q1[3] * q1[3]);
                        u32x4 w; w.x = pk2(q0[0], q0[1]); w.y = pk2(q0[2], q0[3]); w.z = pk2(q1[0], q1[1]); w.w = pk2(q1[2], q1[3]);
                        *(u32x4*)(XB + (size_t)row * DM + i * 512 + lane * 8) = w;
                    }
#pragma unroll
                    for (int o = 32; o >= 1; o >>= 1) ss += __shfl_xor(ss, o);
                    if (lane < 16) SS[(size_t)row * 16 + lane] = (lane == 0) ? f2bf(ss) : (bf16_t)0;
                }
            }
        }
    }
}

__device__ __forceinline__ void stage_kv(bf16_t* kS, bf16_t* vS, const bf16_t* PROJ, int row0, int h, int lane, float l2g, int e0, bool do_k) {
    const int r = lane >> 3, pc = (lane & 7) * 8;
    const bf16_t* rp = PROJ + (size_t)(row0 + r) * NIN + h * 64 + pc;
    u32x4 kr[8], vr[8];
    if (do_k) {
#pragma unroll
        for (int i = 0; i < 8; ++i) kr[i] = *(const u32x4*)(rp + (size_t)(8 * i) * NIN + PC_K);
    }
#pragma unroll
    for (int i = 0; i < 8; ++i) vr[i] = *(const u32x4*)(rp + (size_t)(8 * i) * NIN + PC_VV);
    if (do_k) {
        float f = exp2f(l2g * (float)(e0 - r));
        const float st = exp2f(-8.0f * l2g);
#pragma unroll
        for (int i = 0; i < 8; ++i) {
            u32x4 w;
            w.x = pk2(bflo(kr[i].x) * f, bfhi(kr[i].x) * f); w.y = pk2(bflo(kr[i].y) * f, bfhi(kr[i].y) * f);
            w.z = pk2(bflo(kr[i].z) * f, bfhi(kr[i].z) * f); w.w = pk2(bflo(kr[i].w) * f, bfhi(kr[i].w) * f);
            *(u32x4*)(kS + (r + 8 * i) * 72 + pc) = w;
            f *= st;
        }
    }
#pragma unroll
    for (int i = 0; i < 8; ++i) *(u32x4*)(vS + (r + 8 * i) * 72 + pc) = vr[i];
}

typedef short s16x4 __attribute__((ext_vector_type(4)));
__device__ __forceinline__ bf16x8 tr_frag(const bf16_t* X, int ld, int krow0, int krow1, int idx0, int fr) {
    const int q = fr >> 2, p4 = (fr & 3) * 4;
    const s16x4 lo = __builtin_amdgcn_ds_read_tr16_b64_v4i16((LAS s16x4*)(X + (krow0 + q) * ld + idx0 + p4));
    const s16x4 hi = __builtin_amdgcn_ds_read_tr16_b64_v4i16((LAS s16x4*)(X + (krow1 + q) * ld + idx0 + p4));
    bf16x8 r; r[0] = lo[0]; r[1] = lo[1]; r[2] = lo[2]; r[3] = lo[3]; r[4] = hi[0]; r[5] = hi[1]; r[6] = hi[2]; r[7] = hi[3];
    return r;
}
#define MFMA16(a, b, c) __builtin_amdgcn_mfma_f32_16x16x32_bf16((a), (b), (c), 0, 0, 0)

__device__ __forceinline__ void phase_mix1(const PT& p, unsigned char* lds, int l) {
    unsigned char* ws = p.ws();
    const float* a_vnorm_g_ = p.a_vnorm_g(); const float* a_bs_ = p.a_bs(); const float* b_scale_ = p.b_scale();
    const bf16_t* PROJ = (const bf16_t*)(ws + WS_PROJ); bf16_t* Y = (bf16_t*)(ws + WS_Y); unsigned* KVS = (unsigned*)(ws + WS_KVS);
    const bf16_t* AWS = (const bf16_t*)(ws + WS_AWS); const bf16_t* BWT = (const bf16_t*)(ws + WS_BWT);
    int tid = threadIdx.x; asm volatile("" : "+v"(tid));
    int bid_ = blockIdx.x, G_ = gridDim.x; asm volatile("" : "+s"(bid_), "+s"(G_));
    const int wave = __builtin_amdgcn_readfirstlane(tid >> 6), lane = tid & 63, fr = lane & 15, fq = lane >> 4;
#pragma unroll 1
    for (int u = bid_; u < MTOK / 128; u += G_) {
        const int R0 = u * 128;
        __syncthreads();
        {
            bf16_t* vnS = (bf16_t*)lds;
            const int rr = tid >> 5, pc = (tid & 31) * 8;
            const bf16_t* src = PROJ + (size_t)(R0 + rr) * NIN + PC_V + pc;
            u32x4 raw[8];
#pragma unroll
            for (int i = 0; i < 8; ++i) raw[i] = *(const u32x4*)(src + (size_t)(16 * i) * NIN);
            f32x4 ga0 = *(const f32x4*)(a_vnorm_g_ + l * 256 + pc), ga1 = *(const f32x4*)(a_vnorm_g_ + l * 256 + pc + 4);
#pragma unroll
            for (int i = 0; i < 8; ++i) {
                const float a0 = bflo(raw[i].x), a1 = bfhi(raw[i].x), a2 = bflo(raw[i].y), a3 = bfhi(raw[i].y), a4 = bflo(raw[i].z), a5 = bfhi(raw[i].z), a6 = bflo(raw[i].w), a7 = bfhi(raw[i].w);
                float ss = (a0 * a0 + a1 * a1) + (a2 * a2 + a3 * a3) + (a4 * a4 + a5 * a5) + (a6 * a6 + a7 * a7);
                ss += __shfl_xor(ss, 1); ss += __shfl_xor(ss, 2); ss += __shfl_xor(ss, 4); ss += __shfl_xor(ss, 8); ss += __shfl_xor(ss, 16);
                const float rstd = rsqrtf(ss * (1.0f / 256.0f) + 1e-6f);
                u32x4 w;
                w.x = pk2(a0 * rstd * ga0[0], a1 * rstd * ga0[1]); w.y = pk2(a2 * rstd * ga0[2], a3 * rstd * ga0[3]);
                w.z = pk2(a4 * rstd * ga1[0], a5 * rstd * ga1[1]); w.w = pk2(a6 * rstd * ga1[2], a7 * rstd * ga1[3]);
                *(u32x4*)(vnS + (rr + 16 * i) * 264 + pc) = w;
            }
            __syncthreads();
            const int h = wave >> 1, mh = wave & 1, kmax = mh ? 4 : 2;
            const bf16_t* Wa = AWS + (size_t)(l * 4 + h) * 128 * 128;
            const float* bs = a_bs_ + (l * 4 + h) * 128;
#pragma unroll 1
            for (int mt = 0; mt < 4; ++mt) {
                const int t0 = mh * 64 + mt * 16;
                const size_t rowi = (size_t)(R0 + t0 + fr);
                bf16x8 wf[4];
#pragma unroll
                for (int ks = 0; ks < 4; ++ks) wf[ks] = *(const bf16x8*)(Wa + (t0 + fr) * 128 + ks * 32 + fq * 8);
                u32x2 uu[4];
#pragma unroll
                for (int nt = 0; nt < 4; ++nt) uu[nt] = *(const u32x2*)(PROJ + rowi * NIN + PC_U + h * 64 + nt * 16 + fq * 4);
                const float bsv = bs[t0 + fr];
                f32x4 acc[4];
#pragma unroll
                for (int nt = 0; nt < 4; ++nt) acc[nt] = (f32x4){0.f, 0.f, 0.f, 0.f};
#pragma unroll
                for (int ks = 0; ks < 4; ++ks) {
                    if (ks < kmax) {
#pragma unroll
                        for (int nt = 0; nt < 4; ++nt) {
                            const bf16x8 vv = tr_frag(vnS, 264, ks * 32 + fq * 8, ks * 32 + fq * 8 + 4, h * 64 + nt * 16, fr);
                            acc[nt] = MFMA16(vv, wf[ks], acc[nt]);
                        }
                    }
                }
#pragma unroll
                for (int nt = 0; nt < 4; ++nt) {
                    u32x2 w;
                    w.x = pk2(bflo(uu[nt].x) * (acc[nt][0] + bsv), bfhi(uu[nt].x) * (acc[nt][1] + bsv));
                    w.y = pk2(bflo(uu[nt].y) * (acc[nt][2] + bsv), bfhi(uu[nt].y) * (acc[nt][3] + bsv));
                    *(u32x2*)(Y + rowi * DM + h * 64 + nt * 16 + fq * 4) = w;
                }
            }
            __syncthreads();
        }
        {
            bf16_t* pooled = (bf16_t*)lds;
            {
                const int g8 = tid & 31, tseg = tid >> 5;
                const int ch0 = g8 * 8, win = 2 << (ch0 >> 6);
                const int tl0 = tseg * 8, pos0 = (u & 63) * 128 + tl0;
                const bf16_t* xp = PROJ + (size_t)(R0 + tl0) * NIN + PC_XB + ch0;
                float a8[8];
#pragma unroll
                for (int e = 0; e < 8; ++e) a8[e] = 0.f;
#pragma unroll
                for (int i = 1; i < 16; ++i) {
                    if (i < win && pos0 - i >= 0) {
                        const u32x4 r = *(const u32x4*)(xp - (ptrdiff_t)i * NIN);
                        a8[0] += bflo(r.x); a8[1] += bfhi(r.x); a8[2] += bflo(r.y); a8[3] += bfhi(r.y); a8[4] += bflo(r.z); a8[5] += bfhi(r.z); a8[6] += bflo(r.w); a8[7] += bfhi(r.w);
                    }
                }
#pragma unroll
                for (int r8 = 0; r8 < 8; ++r8) {
                    const u32x4 r = *(const u32x4*)(xp + (ptrdiff_t)r8 * NIN);
                    const float c0 = bflo(r.x), c1 = bfhi(r.x), c2 = bflo(r.y), c3 = bfhi(r.y), c4 = bflo(r.z), c5 = bfhi(r.z), c6 = bflo(r.w), c7 = bfhi(r.w);
                    a8[0] += c0; a8[1] += c1; a8[2] += c2; a8[3] += c3; a8[4] += c4; a8[5] += c5; a8[6] += c6; a8[7] += c7;
                    const int pos = pos0 + r8;
                    const float inv = 1.0f / (float)((pos + 1 < win) ? pos + 1 : win);
                    u32x4 w;
                    w.x = pk2(a8[0] * inv - c0, a8[1] * inv - c1); w.y = pk2(a8[2] * inv - c2, a8[3] * inv - c3);
                    w.z = pk2(a8[4] * inv - c4, a8[5] * inv - c5); w.w = pk2(a8[6] * inv - c6, a8[7] * inv - c7);
                    *(u32x4*)(pooled + (tl0 + r8) * 264 + ch0) = w;
                    const int o = r8 - win + 1;
                    if (pos0 + o >= 0) {
                        const u32x4 q = *(const u32x4*)(xp + (ptrdiff_t)o * NIN);
                        a8[0] -= bflo(q.x); a8[1] -= bfhi(q.x); a8[2] -= bflo(q.y); a8[3] -= bfhi(q.y); a8[4] -= bflo(q.z); a8[5] -= bfhi(q.z); a8[6] -= bflo(q.w); a8[7] -= bfhi(q.w);
                    }
                }
            }
            __syncthreads();
            const int g = wave >> 1, mh = wave & 1;
            const bf16_t* Wb = BWT + (size_t)(l * 4 + g) * 64 * 64;
            const float* bsc = b_scale_ + l * 256 + g * 64;
            f32x4 bsv[4];
#pragma unroll
            for (int nt = 0; nt < 4; ++nt) bsv[nt] = *(const f32x4*)(bsc + nt * 16 + fq * 4);
#pragma unroll 1
            for (int mt = 0; mt < 4; ++mt) {
                const int t0 = mh * 64 + mt * 16;
                f32x4 acc[4];
#pragma unroll
                for (int nt = 0; nt < 4; ++nt) acc[nt] = (f32x4){0.f, 0.f, 0.f, 0.f};
#pragma unroll
                for (int ks = 0; ks < 2; ++ks) {
                    const bf16x8 pf = *(const bf16x8*)(pooled + (t0 + fr) * 264 + g * 64 + ks * 32 + fq * 8);
#pragma unroll
                    for (int nt = 0; nt < 4; ++nt) {
                        const bf16x8 wv = *(const bf16x8*)(Wb + (nt * 16 + fr) * 64 + ks * 32 + fq * 8);
                        acc[nt] = MFMA16(wv, pf, acc[nt]);
                    }
                }
#pragma unroll
                for (int nt = 0; nt < 4; ++nt) {
                    const f32x4 o = acc[nt] * bsv[nt];
                    u32x2 w; w.x = pk2(o[0], o[1]); w.y = pk2(o[2], o[3]);
                    *(u32x2*)(Y + (size_t)(R0 + t0 + fr) * DM + 256 + g * 64 + nt * 16 + fq * 4) = w;
                }
            }
            __syncthreads();
        }
        {
            const int h = wave;
            bf16_t* kdT = (bf16_t*)(lds + wave * 18432); bf16_t* vT = kdT + 64 * 72;
            const float l2g = log2_gamma(h);
            f32x4 T[4][4];
#pragma unroll
            for (int a = 0; a < 4; ++a)
#pragma unroll
                for (int b = 0; b < 4; ++b) T[a][b] = (f32x4){0.f, 0.f, 0.f, 0.f};
#pragma unroll 1
            for (int nn = 0; nn < 2; ++nn) {
                const int n = 1 - nn;
                stage_kv(kdT, vT, PROJ, R0 + 64 * n, h, lane, l2g, 127 - 64 * n, true);
                asm volatile("s_waitcnt lgkmcnt(0)" ::: "memory");
#pragma unroll
                for (int ks = 0; ks < 2; ++ks) {
                    bf16x8 a[4], b[4];
#pragma unroll
                    for (int i = 0; i < 4; ++i) { a[i] = tr_frag(kdT, 72, ks * 32 + fq * 8, ks * 32 + fq * 8 + 4, i * 16, fr); b[i] = tr_frag(vT, 72, ks * 32 + fq * 8, ks * 32 + fq * 8 + 4, i * 16, fr); }
#pragma unroll
                    for (int md = 0; md < 4; ++md)
#pragma unroll
                        for (int ne = 0; ne < 4; ++ne) T[md][ne] = MFMA16(a[md], b[ne], T[md][ne]);
                }
                asm volatile("s_waitcnt lgkmcnt(0)" ::: "memory");
            }
            unsigned* dst = KVS + (size_t)(u * 8 + h) * 2048 + lane;
#pragma unroll
            for (int md = 0; md < 4; ++md)
#pragma unroll
                for (int ne = 0; ne < 4; ++ne)
#pragma unroll
                    for (int rp = 0; rp < 2; ++rp) dst[((md * 4 + ne) * 2 + rp) * 64] = pk2(T[md][ne][2 * rp], T[md][ne][2 * rp + 1]);
        }
    }
}

__device__ __forceinline__ void phase_scan(const PT& p) {
    unsigned* KVS = (unsigned*)(p.ws() + WS_KVS);
    int tid = threadIdx.x; asm volatile("" : "+v"(tid));
    int bid_ = blockIdx.x, G_ = gridDim.x; asm volatile("" : "+s"(bid_), "+s"(G_));
    for (int e = bid_ * NTHR + tid; e < 4 * 8 * 2048; e += G_ * NTHR) {
        const int b = e >> 14, h = (e >> 11) & 7, i = e & 2047;
        const float dec = exp2f(log2_gamma(h) * 128.0f);
        unsigned* base = KVS + ((size_t)(b * 64) * 8 + h) * 2048 + i;
        float s0 = 0.f, s1 = 0.f;
#pragma unroll 1
        for (int u0 = 0; u0 < 64; u0 += 16) {
            unsigned t[16];
#pragma unroll
            for (int j = 0; j < 16; ++j) t[j] = base[(size_t)(u0 + j) * 8 * 2048];
#pragma unroll
            for (int j = 0; j < 16; ++j) { base[(size_t)(u0 + j) * 8 * 2048] = pk2(s0, s1); s0 = s0 * dec + bflo(t[j]); s1 = s1 * dec + bfhi(t[j]); }
        }
    }
}

__device__ __forceinline__ void phase_mix3(const PT& p, unsigned char* lds, int l) {
    unsigned char* ws = p.ws();
    const bf16_t* PROJ = (const bf16_t*)(ws + WS_PROJ); bf16_t* Y = (bf16_t*)(ws + WS_Y); const unsigned* KVS = (const unsigned*)(ws + WS_KVS);
    int tid = threadIdx.x; asm volatile("" : "+v"(tid));
    int bid_ = blockIdx.x, G_ = gridDim.x; asm volatile("" : "+s"(bid_), "+s"(G_));
    const int wave = __builtin_amdgcn_readfirstlane(tid >> 6), lane = tid & 63, fr = lane & 15, fq = lane >> 4;
    const int h = wave;
    bf16_t* kdT = (bf16_t*)(lds + wave * 18432); bf16_t* vT = kdT + 64 * 72;
    const float l2g = log2_gamma(h);
    const float dec64 = exp2f(l2g * 64.0f);
    const bool cached = (G_ >= MTOK / 128);
    const float spre = cached ? dec64 * dec64 : dec64, spost = cached ? exp2f(-l2g * 64.0f) : 1.0f;
    const float lanep = exp2f(l2g * (float)(fr - 4 * fq)), lanem = exp2f(l2g * (float)(4 * fq - fr));
    const float cm1 = exp2f(-l2g), cm2 = exp2f(-2.0f * l2g), cm3 = exp2f(-3.0f * l2g), cp1 = exp2f(l2g), cp2 = exp2f(2.0f * l2g), cp3 = exp2f(3.0f * l2g);
    const float d16 = exp2f(l2g * 16.0f), d32 = exp2f(l2g * 32.0f), d48 = exp2f(l2g * 48.0f);
    const float* cg = p.c_norm_g() + l * 512 + h * 64;
#pragma unroll 1
    for (int u = bid_; u < MTOK / 128; u += G_) {
        f32x4 S[4][4];
        {
            const unsigned* src = KVS + (size_t)(u * 8 + h) * 2048 + lane;
#pragma unroll
            for (int md = 0; md < 4; ++md)
#pragma unroll
                for (int ne = 0; ne < 4; ++ne)
#pragma unroll
                    for (int rp = 0; rp < 2; ++rp) { const unsigned w = src[((md * 4 + ne) * 2 + rp) * 64]; S[md][ne][2 * rp] = bflo(w); S[md][ne][2 * rp + 1] = bfhi(w); }
        }
#pragma unroll 1
        for (int n = 0; n < 2; ++n) {
            const int R = u * 128 + n * 64;
            bf16x8 kf[4][2];
#pragma unroll
            for (int ms = 0; ms < 4; ++ms)
#pragma unroll
                for (int ks = 0; ks < 2; ++ks) kf[ms][ks] = *(const bf16x8*)(PROJ + (size_t)(R + ms * 16 + fr) * NIN + PC_K + h * 64 + ks * 32 + fq * 8);
            asm volatile("s_waitcnt lgkmcnt(0)" ::: "memory");
            if (!(cached && n == 0)) stage_kv(kdT, vT, PROJ, R, h, lane, l2g, 63, n == 0);
            asm volatile("s_waitcnt lgkmcnt(0)" ::: "memory");
            bf16x8 Sb[2][4];
#pragma unroll
            for (int ks = 0; ks < 2; ++ks)
#pragma unroll
                for (int ne = 0; ne < 4; ++ne) {
                    const f32x4 lo = S[2 * ks][ne], hi = S[2 * ks + 1][ne];
                    u32x4 w; w.x = pk2(lo[0], lo[1]); w.y = pk2(lo[2], lo[3]); w.z = pk2(hi[0], hi[1]); w.w = pk2(hi[2], hi[3]);
                    Sb[ks][ne] = __builtin_bit_cast(bf16x8, w);
                }
#pragma unroll 1
            for (int mt = 0; mt < 4; ++mt) {
                const size_t rowi = (size_t)(R + mt * 16 + fr);
                const bf16_t* qrow = PROJ + rowi * NIN + PC_Q + h * 64;
                u32x2 gate[4];
#pragma unroll
                for (int ne = 0; ne < 4; ++ne) gate[ne] = *(const u32x2*)(PROJ + rowi * NIN + PC_G + h * 64 + ne * 16 + fq * 4);
                f32x4 sc[4];
#pragma unroll
                for (int ms = 0; ms < 4; ++ms) sc[ms] = (f32x4){0.f, 0.f, 0.f, 0.f};
#pragma unroll
                for (int ks = 0; ks < 2; ++ks) {
                    const bf16x8 bq = *(const bf16x8*)(qrow + ks * 32 + fq * 8);
#pragma unroll
                    for (int ms = 0; ms < 4; ++ms) sc[ms] = MFMA16(kf[ms][ks], bq, sc[ms]);
                }
                bf16x8 Pf[2];
                {
#pragma unroll
                    for (int ms = 0; ms < 4; ++ms) {
                        if (ms == mt) {
#pragma unroll
                            for (int rg = 0; rg < 4; ++rg) { const int e = fr - 4 * fq - rg; sc[ms][rg] *= __builtin_amdgcn_exp2f(l2g * (float)(e < 0 ? -e : e)); }
                        } else {
                            const int dk = (ms < mt) ? (mt - ms) : (ms - mt);
                            const float f = ((ms < mt) ? lanep : lanem) * ((dk == 1) ? d16 : (dk == 2) ? d32 : d48);
                            if (ms < mt) { sc[ms][0] *= f; sc[ms][1] *= f * cm1; sc[ms][2] *= f * cm2; sc[ms][3] *= f * cm3; }
                            else         { sc[ms][0] *= f; sc[ms][1] *= f * cp1; sc[ms][2] *= f * cp2; sc[ms][3] *= f * cp3; }
                        }
                    }
#pragma unroll
                    for (int ks = 0; ks < 2; ++ks) {
                        const f32x4 lo = sc[2 * ks], hi = sc[2 * ks + 1];
                        u32x4 w; w.x = pk2(lo[0], lo[1]); w.y = pk2(lo[2], lo[3]); w.z = pk2(hi[0], hi[1]); w.w = pk2(hi[2], hi[3]);
                        Pf[ks] = __builtin_bit_cast(bf16x8, w);
                    }
                }
                f32x4 yi[4], yc[4];
#pragma unroll
                for (int ne = 0; ne < 4; ++ne) { yi[ne] = (f32x4){0.f, 0.f, 0.f, 0.f}; yc[ne] = (f32x4){0.f, 0.f, 0.f, 0.f}; }
#pragma unroll
                for (int ks = 0; ks < 2; ++ks) {
                    const u32x2 q0 = *(const u32x2*)(qrow + ks * 32 + fq * 4), q1 = *(const u32x2*)(qrow + ks * 32 + 16 + fq * 4);
                    u32x4 qa; qa.x = q0.x; qa.y = q0.y; qa.z = q1.x; qa.w = q1.y;
                    const bf16x8 aq = __builtin_bit_cast(bf16x8, qa);
#pragma unroll
                    for (int ne = 0; ne < 4; ++ne) {
                        const bf16x8 vb = tr_frag(vT, 72, ks * 32 + fq * 4, ks * 32 + 16 + fq * 4, ne * 16, fr);
                        yi[ne] = MFMA16(vb, Pf[ks], yi[ne]);
                        yc[ne] = MFMA16(Sb[ks][ne], aq, yc[ne]);
                    }
                }
                {
                    const float qd = __builtin_amdgcn_exp2f(l2g * (float)(mt * 16 + fr + 1));
                    float s1 = 0.f;
#pragma unroll
                    for (int ne = 0; ne < 4; ++ne) { yi[ne] = yi[ne] + yc[ne] * qd; s1 += (yi[ne][0] + yi[ne][1]) + (yi[ne][2] + yi[ne][3]); }
                    s1 += __shfl_xor(s1, 16); s1 += __shfl_xor(s1, 32);
                    const float mu = s1 * (1.0f / 64.0f);
                    float s2 = 0.f;
#pragma unroll
                    for (int ne = 0; ne < 4; ++ne) { yi[ne] = yi[ne] - mu; s2 += (yi[ne][0] * yi[ne][0] + yi[ne][1] * yi[ne][1]) + (yi[ne][2] * yi[ne][2] + yi[ne][3] * yi[ne][3]); }
                    s2 += __shfl_xor(s2, 16); s2 += __shfl_xor(s2, 32);
                    const float rstd = rsqrtf(s2 * (1.0f / 64.0f) + 1e-6f);
#pragma unroll
                    for (int ne = 0; ne < 4; ++ne) {
                        const f32x4 cgv = *(const f32x4*)(cg + ne * 16 + fq * 4);
                        const f32x4 o = yi[ne] * rstd * cgv;
                        u32x2 w;
                        w.x = pk2(bflo(gate[ne].x) * o[0], bfhi(gate[ne].x) * o[1]);
                        w.y = pk2(bflo(gate[ne].y) * o[2], bfhi(gate[ne].y) * o[3]);
                        *(u32x2*)(Y + rowi * DM + 512 + h * 64 + ne * 16 + fq * 4) = w;
                    }
                }
            }
            if (n == 0) {
#pragma unroll
                for (int md = 0; md < 4; ++md)
#pragma unroll
                    for (int ne = 0; ne < 4; ++ne) S[md][ne] = S[md][ne] * spre;
#pragma unroll
                for (int ks = 0; ks < 2; ++ks) {
                    bf16x8 a[4], b[4];
#pragma unroll
                    for (int i = 0; i < 4; ++i) { a[i] = tr_frag(kdT, 72, ks * 32 + fq * 8, ks * 32 + fq * 8 + 4, i * 16, fr); b[i] = tr_frag(vT, 72, ks * 32 + fq * 8, ks * 32 + fq * 8 + 4, i * 16, fr); }
#pragma unroll
                    for (int md = 0; md < 4; ++md)
#pragma unroll
                        for (int ne = 0; ne < 4; ++ne) S[md][ne] = MFMA16(a[md], b[ne], S[md][ne]);
                }
#pragma unroll
                for (int md = 0; md < 4; ++md)
#pragma unroll
                    for (int ne = 0; ne < 4; ++ne) S[md][ne] = S[md][ne] * spost;
            }
        }
    }
}

__device__ __forceinline__ void phase_fixup(const PT& p, int l) {
    int tid = threadIdx.x; asm volatile("" : "+v"(tid));
    int bid_ = blockIdx.x, G_ = gridDim.x; asm volatile("" : "+s"(bid_), "+s"(G_));
    unsigned char* ws = p.ws(); const bf16_t* HALO = (const bf16_t*)(ws + WS_HALO); bf16_t* ACT = (bf16_t*)(ws + WS_PROJ);
    const float* cw = p.conv_w() + (size_t)l * 3 * NUP; const float* cb = p.conv_b() + (size_t)l * NUP;
    const f32x4 z = {0.f, 0.f, 0.f, 0.f};
#define HLD(ptr) ({ const u32x2 q_ = *(const u32x2*)(ptr); f32x4 r_; r_[0] = bflo(q_.x); r_[1] = bfhi(q_.x); r_[2] = bflo(q_.y); r_[3] = bfhi(q_.y); r_; })
    for (int i = bid_ * NTHR + tid; i < 512 * (DFF / 4); i += G_ * NTHR) {
        const int S = i / (DFF / 4), c = (i % (DFF / 4)) * 4;
        const int tg = (c >> 7) * 256 + (c & 127), tv = tg + 128;
        const bool first = (S & 127) == 0;
        const bf16_t* h0 = HALO + (size_t)S * 4 * NUP; const bf16_t* hp = HALO + (size_t)(first ? S : S - 1) * 4 * NUP;
        f32x4 g_m2 = HLD(hp + 2 * NUP + tg), g_m1 = HLD(hp + 3 * NUP + tg);
        f32x4 v_m2 = HLD(hp + 2 * NUP + tv), v_m1 = HLD(hp + 3 * NUP + tv);
        const f32x4 g_0 = HLD(h0 + tg), g_1 = HLD(h0 + NUP + tg), v_0 = HLD(h0 + tv), v_1 = HLD(h0 + NUP + tv);
        if (first) { g_m2 = z; g_m1 = z; v_m2 = z; v_m1 = z; }
        const f32x4 wg0 = *(const f32x4*)(cw + c), wg1 = *(const f32x4*)(cw + NUP + c), wg2 = *(const f32x4*)(cw + 2 * NUP + c), bg = *(const f32x4*)(cb + c);
        const f32x4 wv0 = *(const f32x4*)(cw + DFF + c), wv1 = *(const f32x4*)(cw + NUP + DFF + c), wv2 = *(const f32x4*)(cw + 2 * NUP + DFF + c), bv = *(const f32x4*)(cb + DFF + c);
        const f32x4 cg0 = bg + wg0 * g_m2 + wg1 * g_m1 + wg2 * g_0, cv0 = bv + wv0 * v_m2 + wv1 * v_m1 + wv2 * v_0;
        const f32x4 cg1 = bg + wg0 * g_m1 + wg1 * g_0 + wg2 * g_1, cv1 = bv + wv0 * v_m1 + wv1 * v_0 + wv2 * v_1;
        u32x2 w0, w1;
        w0.x = pk2(silu_f(cg0[0]) * cv0[0], silu_f(cg0[1]) * cv0[1]); w0.y = pk2(silu_f(cg0[2]) * cv0[2], silu_f(cg0[3]) * cv0[3]);
        w1.x = pk2(silu_f(cg1[0]) * cv1[0], silu_f(cg1[1]) * cv1[1]); w1.y = pk2(silu_f(cg1[2]) * cv1[2], silu_f(cg1[3]) * cv1[3]);
        *(u32x2*)(ACT + (size_t)(S * 64) * DFF + c) = w0;
        *(u32x2*)(ACT + (size_t)(S * 64 + 1) * DFF + c) = w1;
    }
}

__device__ __forceinline__ void phase_final(const PT& p) {
    int tid = threadIdx.x; asm volatile("" : "+v"(tid));
    int bid_ = blockIdx.x, G_ = gridDim.x; asm volatile("" : "+s"(bid_), "+s"(G_));
    unsigned char* ws = p.ws();
    const bf16_t* SS = (const bf16_t*)(ws + WS_SS); const bf16_t* XB = (const bf16_t*)(ws + WS_XB);
    const int wave = tid >> 6, lane = tid & 63;
    float* outp = p.out(); const float* fg = p.final_g();
    f32x4 g[4];
#pragma unroll
    for (int i = 0; i < 2; ++i) { g[2 * i] = *(const f32x4*)(fg + i * 512 + lane * 8); g[2 * i + 1] = *(const f32x4*)(fg + i * 512 + lane * 8 + 4); }
    const int rstride = G_ * 8;
    for (int row0 = bid_ * 8 + wave; row0 < MTOK; row0 += 8 * rstride) {
        u32x4 r[8][2]; float rs[8];
#pragma unroll
        for (int q = 0; q < 8; ++q) {
            const int row = (row0 + q * rstride < MTOK) ? row0 + q * rstride : row0;
            rs[q] = rstd_from_ss(SS, row);
#pragma unroll
            for (int i = 0; i < 2; ++i) r[q][i] = *(const u32x4*)(XB + (size_t)row * DM + i * 512 + lane * 8);
        }
#pragma unroll
        for (int q = 0; q < 8; ++q) {
            const int row = row0 + q * rstride;
            if (row < MTOK) {
#pragma unroll
                for (int i = 0; i < 2; ++i) {
                    f32x4 v0, v1; v0[0] = bflo(r[q][i].x); v0[1] = bfhi(r[q][i].x); v0[2] = bflo(r[q][i].y); v0[3] = bfhi(r[q][i].y);
                    v1[0] = bflo(r[q][i].z); v1[1] = bfhi(r[q][i].z); v1[2] = bflo(r[q][i].w); v1[3] = bfhi(r[q][i].w);
                    float* op = outp + (size_t)row * DM + i * 512 + lane * 8;
                    *(f32x4*)op = v0 * rs[q] * g[2 * i];
                    *(f32x4*)(op + 4) = v1 * rs[q] * g[2 * i + 1];
                }
            }
        }
    }
}

template <int l>
__device__ __forceinline__ void run_layer(const PT& pt, unsigned char* lds, LAS unsigned char* ldsl, cg::grid_group& grid) {
        {
            unsigned char* ws = pt.ws();
            pg8::Gemm g{(const bf16_t*)(ws + WS_XB), (const bf16_t*)(ws + WS_WIN) + (size_t)l * NIN * DM, MTOK, NIN, DM};
            int bid_ = blockIdx.x, G_ = gridDim.x; asm volatile("" : "+s"(bid_), "+s"(G_)); pg8::StaticOrder S; S.init(MTOK, NIN, G_, bid_, 1);
            EpiProj E{(bf16_t*)(ws + WS_PROJ), (const bf16_t*)(ws + WS_SS)};
            pg8::gemm_phase<EpiProj, pg8::StaticOrder>(ldsl, g, S, E);
            if (DUP_G13) pg8::gemm_phase<EpiProj, pg8::StaticOrder>(ldsl, g, S, E);
            if (l == 0 && G_ == 256 && bid_ >= 128) {
                int tid_ = threadIdx.x; asm volatile("" : "+v"(tid_));
                for (int job = bid_ - 128; job < 768; job += 128)
                    wconv_job((float*)lds, ws, pt.raw(2), pt.raw(9), pt.raw(11), pt.raw(14), pt.raw(1), pt.raw(10), 1, job, tid_);
            }
        }
        GSYNC();
        phase_mix1(pt, lds, l);
        if (DUP_MIX) phase_mix1(pt, lds, l);
        GSYNC();
        phase_scan(pt);
        GSYNC();
        phase_mix3(pt, lds, l);
        if (DUP_MIX) phase_mix3(pt, lds, l);
        GSYNC();
        {
            unsigned char* ws = pt.ws();
            pg8::Gemm g{(const bf16_t*)(ws + WS_Y), (const bf16_t*)(ws + WS_WOUT) + (size_t)l * DM * DM, MTOK, DM, DM};
            int bid_ = blockIdx.x, G_ = gridDim.x; asm volatile("" : "+s"(bid_), "+s"(G_)); pg8::StaticOrder S; S.init(MTOK, DM, G_, bid_);
            EpiRes E{(bf16_t*)(ws + WS_XB), (bf16_t*)(ws + WS_SS)};
            pg8::gemm_phase<EpiRes, pg8::StaticOrder>(ldsl, g, S, E);
        }
        GSYNC();
        {
            unsigned char* ws = pt.ws();
            pg8::Gemm g{(const bf16_t*)(ws + WS_XB), (const bf16_t*)(ws + WS_WUP) + (size_t)l * NUP * DM, MTOK, NUP, DM};
            int bid_ = blockIdx.x, G_ = gridDim.x; asm volatile("" : "+s"(bid_), "+s"(G_)); pg8::StaticOrder S; S.init(MTOK, NUP, G_, bid_, 1);
            EpiUp E{ws, pt.conv_w() + (size_t)l * 3 * NUP, pt.conv_b() + (size_t)l * NUP};
            pg8::gemm_phase<EpiUp, pg8::StaticOrder>(ldsl, g, S, E);
            if (DUP_G13) pg8::gemm_phase<EpiUp, pg8::StaticOrder>(ldsl, g, S, E);
        }
        GSYNC();
        phase_fixup(pt, l);
        if (DUP_MISC) phase_fixup(pt, l);
        GSYNC();
        {
            unsigned char* ws = pt.ws();
            pg8::Gemm g{(const bf16_t*)(ws + WS_PROJ), (const bf16_t*)(ws + WS_WDN) + (size_t)l * DM * DFF, MTOK, DM, DFF};
            int bid_ = blockIdx.x, G_ = gridDim.x; asm volatile("" : "+s"(bid_), "+s"(G_)); pg8::StaticOrder S; S.init(MTOK, DM, G_, bid_);
            EpiRes E{(bf16_t*)(ws + WS_XB), (bf16_t*)(ws + WS_SS)};
            pg8::gemm_phase<EpiRes, pg8::StaticOrder>(ldsl, g, S, E);
        }
        GSYNC();
}

__global__ void __launch_bounds__(NTHR, 2) fwd_megakernel(Params p) {
    extern __shared__ __attribute__((aligned(16))) unsigned char lds[];
    cg::grid_group grid = cg::this_grid();
    LAS unsigned char* ldsl = (LAS unsigned char*)lds;
    {
        LAS unsigned long long* tabw = (LAS unsigned long long*)(ldsl + LDS_TAB);
        if (threadIdx.x == 0) {
            tabw[0] = (unsigned long long)p.x; tabw[1] = (unsigned long long)p.norm1_g; tabw[2] = (unsigned long long)p.w_in; tabw[3] = (unsigned long long)p.a_vnorm_g;
            tabw[4] = (unsigned long long)p.a_ws; tabw[5] = (unsigned long long)p.a_bs; tabw[6] = (unsigned long long)p.b_w; tabw[7] = (unsigned long long)p.b_scale;
            tabw[8] = (unsigned long long)p.c_norm_g; tabw[9] = (unsigned long long)p.w_out; tabw[10] = (unsigned long long)p.norm2_g; tabw[11] = (unsigned long long)p.w_up;
            tabw[12] = (unsigned long long)p.conv_w; tabw[13] = (unsigned long long)p.conv_b; tabw[14] = (unsigned long long)p.w_down; tabw[15] = (unsigned long long)p.final_g;
            tabw[16] = (unsigned long long)p.out; tabw[17] = (unsigned long long)p.ws;
            tabw[24] = 0ull;
        }
    }
    if (blockIdx.x == 0) { unsigned* bw = (unsigned*)(p.ws + WS_BAR); for (int i = threadIdx.x; i < XCD_BAR_WORDS; i += NTHR) bw[i] = 0u; }
    phase_prologue(p, lds);
    if (DUP_MISC) phase_prologue(p, lds);
    grid.sync();
    xcd_barrier_post((unsigned*)(p.ws + WS_BAR));
    PT pt; pt.t = (const LAS unsigned long long*)(ldsl + LDS_TAB);
    run_layer<0>(pt, lds, ldsl, grid);
    run_layer<1>(pt, lds, ldsl, grid);
    phase_final(pt);
    if (DUP_MISC) phase_final(pt);
}

extern "C" void kernel_launch(void* const* d_in, const int* in_sizes, int n_in, void* d_out, int out_size, void* d_ws, size_t ws_size, hipStream_t stream) {
    static int grid_blocks = 0;
    if (grid_blocks == 0) {
        if (n_in != 16 || out_size != MTOK * DM || ws_size < WS_END) { fprintf(stderr, "kernel_launch: unexpected shapes (n_in %d out %d ws %zu need %zu)\n", n_in, out_size, ws_size, (size_t)WS_END); grid_blocks = -1; return; }
        int dev = 0, cus = 0, per_cu = 0;
        (void)hipGetDevice(&dev);
        (void)hipDeviceGetAttribute(&cus, hipDeviceAttributeMultiprocessorCount, dev);
        if (hipFuncSetAttribute((const void*)fwd_megakernel, hipFuncAttributeMaxDynamicSharedMemorySize, LDS_BYTES) != hipSuccess) { fprintf(stderr, "kernel_launch: hipFuncSetAttribute failed\n"); grid_blocks = -1; return; }
        if (hipOccupancyMaxActiveBlocksPerMultiprocessor(&per_cu, (const void*)fwd_megakernel, NTHR, LDS_BYTES) != hipSuccess || per_cu < 1) { fprintf(stderr, "kernel_launch: occupancy query says %d\n", per_cu); grid_blocks = -1; return; }
        grid_blocks = cus * (per_cu > 1 ? 1 : per_cu);
    }
    if (grid_blocks < 0) return;
    Params p{};
    p.x = (const float*)d_in[0]; p.norm1_g = (const float*)d_in[1]; p.w_in = (const float*)d_in[2]; p.a_vnorm_g = (const float*)d_in[3];
    p.a_ws = (const float*)d_in[4]; p.a_bs = (const float*)d_in[5]; p.b_w = (const float*)d_in[6]; p.b_scale = (const float*)d_in[7];
    p.c_norm_g = (const float*)d_in[8]; p.w_out = (const float*)d_in[9]; p.norm2_g = (const float*)d_in[10]; p.w_up = (const float*)d_in[11];
    p.conv_w = (const float*)d_in[12]; p.conv_b = (const float*)d_in[13]; p.w_down = (const float*)d_in[14]; p.final_g = (const float*)d_in[15];
    p.out = (float*)d_out; p.ws = (unsigned char*)d_ws;
    void* args[] = {&p};
    hipError_t e = hipLaunchCooperativeKernel((const void*)fwd_megakernel, dim3(grid_blocks), dim3(NTHR), args, LDS_BYTES, stream);
    if (e != hipSuccess) fprintf(stderr, "cooperative launch failed: %s (grid %d)\n", hipGetErrorString(e), grid_blocks);
}
```

```cpp
#include <hip/hip_runtime.h>
#include <hip/hip_cooperative_groups.h>
#include <cstdio>
namespace cg = cooperative_groups;
#ifndef DUP_SYNC
#define DUP_SYNC 0
#endif
#ifndef DUP_MIX
#define DUP_MIX 0
#endif
#ifndef DUP_MISC
#define DUP_MISC 0
#endif
#ifndef DUP_G13
#define DUP_G13 0
#endif
#define GSYNC() do { xcd_barrier((unsigned*)(pt.ws() + WS_BAR), (volatile LAS unsigned*)(ldsl + LDS_TAB + 192)); if (DUP_SYNC) xcd_barrier((unsigned*)(pt.ws() + WS_BAR), (volatile LAS unsigned*)(ldsl + LDS_TAB + 192)); } while (0)

typedef unsigned short bf16_t;
typedef short bf16x8 __attribute__((ext_vector_type(8)));
typedef float f32x4 __attribute__((ext_vector_type(4)));
typedef float f32x2 __attribute__((ext_vector_type(2)));
typedef unsigned u32x4 __attribute__((ext_vector_type(4)));
typedef unsigned u32x2 __attribute__((ext_vector_type(2)));
#define LAS __attribute__((address_space(3)))
#define GAS __attribute__((address_space(1)))

constexpr int MTOK = 32768, DM = 1024, SEQL = 8192, NIN = 2816, NUP = 5632, DFF = 2816, NLAYER = 2;
constexpr int NTHR = 512;
constexpr int LDS_X    = 131072;
constexpr int LDSX_SS  = 0;
constexpr int LDSX_W   = 16384;
constexpr int LDS_TAB  = LDS_X + 24576;
constexpr int LDS_BYTES = LDS_TAB + 256;
constexpr int PC_U = 0, PC_V = 256, PC_XB = 512, PC_Q = 768, PC_K = 1280, PC_VV = 1792, PC_G = 2304;

constexpr size_t WS_WIN  = 0;
constexpr size_t WS_WOUT = WS_WIN  + (size_t)NLAYER * NIN * DM * 2;
constexpr size_t WS_WUP  = WS_WOUT + (size_t)NLAYER * DM * DM * 2;
constexpr size_t WS_WDN  = WS_WUP  + (size_t)NLAYER * NUP * DM * 2;
constexpr size_t WS_AWS  = WS_WDN  + (size_t)NLAYER * DM * DFF * 2;
constexpr size_t WS_BWT  = WS_AWS  + (size_t)NLAYER * 4 * 128 * 128 * 2;
constexpr size_t WS_XB   = WS_BWT  + (size_t)NLAYER * 4 * 64 * 64 * 2;
constexpr size_t WS_SS   = WS_XB   + (size_t)MTOK * DM * 2;
constexpr size_t WS_PROJ = WS_SS   + (size_t)MTOK * 16 * 4;
constexpr size_t WS_Y    = WS_PROJ + (size_t)MTOK * NIN * 2;
constexpr size_t WS_KVS  = WS_Y    + (size_t)MTOK * DM * 2;
constexpr size_t WS_HALO = WS_KVS  + (size_t)256 * 8 * 4096 * 4;
constexpr size_t WS_BAR  = WS_HALO + (size_t)512 * 4 * NUP * 4;
constexpr size_t WS_END  = WS_BAR + 16384;

struct Params {
    const float* x; const float* norm1_g; const float* w_in; const float* a_vnorm_g; const float* a_ws; const float* a_bs;
    const float* b_w; const float* b_scale; const float* c_norm_g; const float* w_out; const float* norm2_g; const float* w_up;
    const float* conv_w; const float* conv_b; const float* w_down; const float* final_g;
    float* out; unsigned char* ws;
};


struct PT {
    const LAS unsigned long long* t;
    __device__ __forceinline__ unsigned long long g(int i) const {
        const unsigned long long v = t[i];
        const unsigned lo = __builtin_amdgcn_readfirstlane((unsigned)v), hi = __builtin_amdgcn_readfirstlane((unsigned)(v >> 32));
        return ((unsigned long long)hi << 32) | lo;
    }
    __device__ __forceinline__ const float* x() const { return (const float*)(GAS const float*)g(0); }
    __device__ __forceinline__ const float* raw(int i) const { return (const float*)(GAS const float*)g(i); }
    __device__ __forceinline__ const float* a_vnorm_g() const { return (const float*)(GAS const float*)g(3); }
    __device__ __forceinline__ const float* a_bs() const { return (const float*)(GAS const float*)g(5); }
    __device__ __forceinline__ const float* b_scale() const { return (const float*)(GAS const float*)g(7); }
    __device__ __forceinline__ const float* c_norm_g() const { return (const float*)(GAS const float*)g(8); }
    __device__ __forceinline__ const float* conv_w() const { return (const float*)(GAS const float*)g(12); }
    __device__ __forceinline__ const float* conv_b() const { return (const float*)(GAS const float*)g(13); }
    __device__ __forceinline__ const float* final_g() const { return (const float*)(GAS const float*)g(15); }
    __device__ __forceinline__ float* out() const { return (float*)(GAS float*)g(16); }
    __device__ __forceinline__ unsigned char* ws() const { return (unsigned char*)(GAS unsigned char*)g(17); }
};


#define XB_TMO      128
#define XB_XCNT(j)  (256  + 64 * (j))
#define XB_XSUB(j)  (1280 + 64 * (j))
#define XB_XGEN(j)  (2304 + 64 * (j))
#define XB_TOP      3328
#define XB_TOPGEN   3392
#define XCD_BAR_WORDS 3456
#define XB_SPIN_CAP (1u << 18)
__device__ __forceinline__ unsigned xb_ld(unsigned* p)              { return __hip_atomic_load(p, __ATOMIC_RELAXED, __HIP_MEMORY_SCOPE_AGENT); }
__device__ __forceinline__ unsigned xb_add(unsigned* p, unsigned v) { return __hip_atomic_fetch_add(p, v, __ATOMIC_RELAXED, __HIP_MEMORY_SCOPE_AGENT); }
__device__ __forceinline__ unsigned xb_xcc_id() { return (unsigned)__builtin_amdgcn_s_getreg((3 << 11) | 20) & 0xFu; }
#define XB_SPIN(cond, bar) do { unsigned _sp = 0; while (cond) { __builtin_amdgcn_s_sleep(1); \
    if ((++_sp & 255u) == 0u) { if (xb_ld(&(bar)[XB_TMO])) break; if (_sp > XB_SPIN_CAP) { atomicAdd(&(bar)[XB_TMO], 1u); break; } } } } while (0)
__device__ __forceinline__ void xcd_barrier_post(unsigned* bar) { if (threadIdx.x == 0) (void)xb_add(&bar[XB_XCNT(xb_xcc_id())], 1u); }
__device__ __forceinline__ void xcd_barrier_complete(unsigned* bar, unsigned x, unsigned& nloc, unsigned& nx) {
    const unsigned G = gridDim.x * gridDim.y * gridDim.z;
    unsigned sum, cnt, mine, sp = 0u;
    for (;;) {
        sum = 0u; cnt = 0u; mine = 0u;
#pragma unroll
        for (unsigned j = 0; j < 16; ++j) { const unsigned c = xb_ld(&bar[XB_XCNT(j)]); sum += c; cnt += (c > 0u) ? 1u : 0u; mine = (j == x) ? c : mine; }
        if (sum == G) break;
        __builtin_amdgcn_s_sleep(1);
        if ((++sp & 255u) == 0u) { if (xb_ld(&bar[XB_TMO])) break; if (sp > XB_SPIN_CAP) { atomicAdd(&bar[XB_TMO], 1u); break; } }
    }
    nloc = mine > 0u ? mine : 1u; nx = cnt > 0u ? cnt : 1u;
}
__device__ __forceinline__ void xcd_barrier(unsigned* bar, volatile LAS unsigned* st) {
    asm volatile("s_waitcnt vmcnt(0)" ::: "memory");
    __syncthreads();
    if (threadIdx.x == 0) {
        const unsigned x = xb_xcc_id();
        __builtin_amdgcn_s_waitcnt(0);
        unsigned nloc = st[0], nx = st[1];
        if (nloc == 0u) { xcd_barrier_complete(bar, x, nloc, nx); st[0] = nloc; st[1] = nx; }
        const unsigned old = xb_add(&bar[XB_XSUB(x)], 1u);
        const unsigned gen = old / nloc;
        if (old + 1u == (gen + 1u) * nloc) {
            __builtin_amdgcn_fence(__ATOMIC_RELEASE, "agent");
            asm volatile("s_waitcnt vmcnt(0)" ::: "memory");
            const unsigned og = xb_add(&bar[XB_TOP], 1u);
            const unsigned tg = og / nx;
            if (og + 1u == (tg + 1u) * nx) xb_add(&bar[XB_TOPGEN], 1u);
            else XB_SPIN(xb_ld(&bar[XB_TOPGEN]) == tg, bar);
            __builtin_amdgcn_fence(__ATOMIC_ACQUIRE, "agent");
            xb_add(&bar[XB_XGEN(x)], 1u);
            asm volatile("s_waitcnt vmcnt(0)" ::: "memory");
        } else {
            XB_SPIN(xb_ld(&bar[XB_XGEN(x)]) == gen, bar);
            __builtin_amdgcn_fence(__ATOMIC_ACQUIRE, "agent");
            asm volatile("s_waitcnt vmcnt(0)" ::: "memory");
        }
    }
    __syncthreads();
}

__device__ __forceinline__ float bf2f(unsigned short b) { return __uint_as_float(((unsigned)b) << 16); }
__device__ __forceinline__ float bflo(unsigned w) { return __uint_as_float(w << 16); }
__device__ __forceinline__ float bfhi(unsigned w) { return __uint_as_float(w & 0xFFFF0000u); }
__device__ __forceinline__ unsigned short f2bf(float f) { unsigned u = __float_as_uint(f); u += 0x7FFFu + ((u >> 16) & 1u); return (unsigned short)(u >> 16); }
__device__ __forceinline__ unsigned pk2(float lo, float hi) { unsigned r; asm("v_cvt_pk_bf16_f32 %0, %1, %2" : "=v"(r) : "v"(lo), "v"(hi)); return r; }
__device__ __forceinline__ float fast_sigmoid(float x) { return __builtin_amdgcn_rcpf(1.0f + __builtin_amdgcn_exp2f(-1.4426950408889634f * x)); }
__device__ __forceinline__ float silu_f(float x) { return x * fast_sigmoid(x); }
__device__ __forceinline__ float gelu_tanh_f(float x) { const float u = 0.7978845608028654f * (x + 0.044715f * x * x * x); return x * fast_sigmoid(2.0f * u); }
__device__ __forceinline__ float ror1(float v) { return __builtin_bit_cast(float, __builtin_amdgcn_mov_dpp(__builtin_bit_cast(int, v), 0x121, 0xf, 0xf, true)); }
__device__ __forceinline__ float ror2(float v) { return __builtin_bit_cast(float, __builtin_amdgcn_mov_dpp(__builtin_bit_cast(int, v), 0x122, 0xf, 0xf, true)); }
__device__ __forceinline__ f32x2 silu2(f32x2 c) { const f32x2 t = c * (-1.4426950408889634f); f32x2 e; e.x = __builtin_amdgcn_exp2f(t.x); e.y = __builtin_amdgcn_exp2f(t.y); const f32x2 d = e + 1.0f; f32x2 r; r.x = __builtin_amdgcn_rcpf(d.x); r.y = __builtin_amdgcn_rcpf(d.y); return c * r; }
__device__ __forceinline__ float log2_gamma(int h) { return log1pf(-exp2f(-5.0f - (float)h)) * 1.4426950408889634f; }
__device__ __forceinline__ float rstd_from_ss(const bf16_t* SS, int row) {
    const u32x4* p = (const u32x4*)(SS + (size_t)row * 16);
    const u32x4 a = p[0], b = p[1];
    const float s = ((bflo(a.x) + bfhi(a.x)) + (bflo(a.y) + bfhi(a.y))) + ((bflo(a.z) + bfhi(a.z)) + (bflo(a.w) + bfhi(a.w)))
                  + ((bflo(b.x) + bfhi(b.x)) + (bflo(b.y) + bfhi(b.y))) + ((bflo(b.z) + bfhi(b.z)) + (bflo(b.w) + bfhi(b.w)));
    return rsqrtf(s * (1.0f / 1024.0f) + 1e-6f);
}
__device__ __forceinline__ float rstd_row_lds(const LAS unsigned char* ssl, int rt, int fq) {
    const u32x2 a = *(const LAS u32x2*)(ssl + rt * 32 + fq * 8);
    float s = (bflo(a.x) + bfhi(a.x)) + (bflo(a.y) + bfhi(a.y));
    s += __shfl_xor(s, 16); s += __shfl_xor(s, 32);
    return rsqrtf(s * (1.0f / 1024.0f) + 1e-6f);
}
__device__ __forceinline__ void prefetch_ss(const bf16_t* SS, LAS unsigned char* ldx, int pm, int par, int wid, int lane) {
    __builtin_amdgcn_global_load_lds((const unsigned*)((const char*)SS + (size_t)pm * 8192 + wid * 1024 + lane * 16), (LAS unsigned*)(ldx + LDSX_SS + par * 8192 + wid * 1024), 16, 0, 0);
}

namespace pg8 {
constexpr int BM = 256, BK = 64, HALF = 128, HTB = HALF * BK * 2, STAGE_BYTES = 8 * HTB, NXCD = 8, WGM = 8;
__host__ __device__ __forceinline__ int lds_byte(int r, int c) { const int st = (r >> 4) * 2 + (c >> 5), rr = r & 15, cc = c & 31, ob = rr * 64 + cc * 2; return st * 1024 + (ob ^ (((ob >> 9) & 1) << 5)); }
__host__ __device__ __forceinline__ void stage_rc(int b, int& R, int& C) { const int st = b / 1024, sb = b % 1024, swz = sb ^ (((sb >> 9) & 1) << 5); R = (st >> 1) * 16 + swz / 64; C = (st & 1) * 32 + (swz % 64) / 2; }
__host__ __device__ __forceinline__ int perm32(int rho) { const int n = rho >> 4, i = rho & 15; return 8 * (i >> 2) + 4 * n + (i & 3); }
struct Unit { int pm, pn; };
struct Gemm { const bf16_t* A; const bf16_t* Bt; int M, N, K; };
struct StaticOrder {
    int nM, nN, nwg, G, c, rev;
    __device__ void init(int M, int N, int G_, int c_, int rev_ = 0) { nM = M / BM; nN = N / BM; nwg = nM * nN; G = G_; c = c_; rev = rev_; }
    __device__ bool next(int i, Unit& u) const {
        const long L = (long)i * G + c; if (L >= nwg) return false;
        int wgid = (int)L; { const int q = nwg / NXCD, r = nwg % NXCD, xcd = wgid % NXCD, off = wgid / NXCD; wgid = (xcd < r ? xcd * (q + 1) : r * (q + 1) + (xcd - r) * q) + off; }
        const int nig = WGM * nN, gid = wgid / nig, fm = gid * WGM, gsz = (nM - fm) < WGM ? (nM - fm) : WGM;
        u.pm = fm + ((wgid % nig) % gsz); u.pn = (wgid % nig) / gsz; if (rev) u.pm = nM - 1 - u.pm; return true;
    }
};

template <class Epi, class Sched>
__device__ __forceinline__ void gemm_phase(LAS unsigned char* lds, const Gemm g, const Sched& S, const Epi& E) {
    LAS unsigned char* ldx = lds + LDS_X;
    int tid = threadIdx.x; asm volatile("" : "+v"(tid));
    const int wid = __builtin_amdgcn_readfirstlane(tid >> 6), lane = tid & 63, wr = wid >> 2, wc = wid & 3, fr = lane & 15, fq = lane >> 4;
    const int K = g.K, nt = K / BK;
    unsigned voffA[2], voffB[2];
#pragma unroll
    for (int i = 0; i < 2; ++i) { int R, C; stage_rc(tid * 16 + i * 8192, R, C); const int Rb = Epi::PERM ? ((R & ~31) + perm32(R & 31)) : R;
        voffA[i] = (unsigned)(R * K + C) * 2u; voffB[i] = (unsigned)(Rb * K + C) * 2u; }
    const size_t kstep = (size_t)(BK * 2);
    const size_t hstep = (size_t)HALF * K * 2;
    const size_t tstep = 2 * hstep;
    const unsigned ldsw = (unsigned)wid * 1024u;
    const int aoff = lds_byte(wr * 64 + fr, fq * 8), boff = lds_byte(wc * 32 + fr, fq * 8);
#define PG8_SA(b, h) (((b) * 2 + (h)) * HTB)
#define PG8_SB(b, h) ((4 + (b) * 2 + (h)) * HTB)
#define PG8_STAGE(bufoff, gbase, voff) do { _Pragma("unroll") for (int _i = 0; _i < 2; ++_i) \
        __builtin_amdgcn_global_load_lds((const unsigned*)((const char*)(gbase) + (voff)[_i]), (LAS unsigned*)(lds + (bufoff) + ldsw + _i * 8192), 16, 0, 0); } while (0)
#define PG8_LDA(dst, b, h) do { _Pragma("unroll") for (int m = 0; m < 4; ++m) _Pragma("unroll") for (int k = 0; k < 2; ++k) dst[m][k] = *(const LAS bf16x8*)(lds + PG8_SA(b, h) + aoff + m * 2048 + k * 1024); } while (0)
#define PG8_LDB(dst, b, h) do { _Pragma("unroll") for (int n = 0; n < 2; ++n) _Pragma("unroll") for (int k = 0; k < 2; ++k) dst[n][k] = *(const LAS bf16x8*)(lds + PG8_SB(b, h) + boff + n * 2048 + k * 1024); } while (0)
#define PG8_MMA(ai, bj, At, Bt) do { __builtin_amdgcn_s_setprio(1); _Pragma("unroll") for (int m = 0; m < 4; ++m) _Pragma("unroll") for (int n = 0; n < 2; ++n) _Pragma("unroll") for (int k = 0; k < 2; ++k) \
        acc[ai][bj][m][n] = __builtin_amdgcn_mfma_f32_16x16x32_bf16(Bt[n][k], At[m][k], acc[ai][bj][m][n], 0, 0, 0); __builtin_amdgcn_s_setprio(0); } while (0)
#define PG8_WAIT_V(n) asm volatile("s_waitcnt vmcnt(" #n ")" ::: "memory")
#define PG8_WAIT_L(n) asm volatile("s_waitcnt lgkmcnt(" #n ")" ::: "memory")
#define PG8_BAR __builtin_amdgcn_s_barrier()
#define PG8_SCHED __builtin_amdgcn_sched_barrier(0)
    Unit cur, nxt; int ui = 0;
    if (!S.next(0, cur)) return;
    f32x4 acc[2][2][4][2];
#pragma unroll
    for (int a = 0; a < 2; ++a)
#pragma unroll
        for (int b = 0; b < 2; ++b)
#pragma unroll
            for (int m = 0; m < 4; ++m)
#pragma unroll
                for (int n = 0; n < 2; ++n) acc[a][b][m][n] = (f32x4){0.f, 0.f, 0.f, 0.f};
    bf16x8 At[4][2], B0[2][2], B1[2][2];
    const char* cA = (const char*)g.A + (size_t)cur.pm * tstep; const char* cB = (const char*)g.Bt + (size_t)cur.pn * tstep;
    E.prefetch(ldx, cur, 0, wid, lane);
    PG8_STAGE(PG8_SB(0, 0), cB, voffB); PG8_STAGE(PG8_SA(0, 0), cA, voffA); PG8_STAGE(PG8_SB(0, 1), cB + hstep, voffB); PG8_STAGE(PG8_SA(0, 1), cA + hstep, voffA);
    if (wr == 1) PG8_BAR;
    PG8_WAIT_V(4); PG8_BAR;
    PG8_STAGE(PG8_SB(1, 0), cB + kstep, voffB); PG8_STAGE(PG8_SA(1, 0), cA + kstep, voffA); PG8_STAGE(PG8_SB(1, 1), cB + hstep + kstep, voffB); PG8_STAGE(PG8_SA(1, 1), cA + hstep + kstep, voffA);
    PG8_WAIT_V(8); PG8_BAR;
    for (;;) {
        const bool has_next = S.next(ui + 1, nxt);
        const char* nA = has_next ? (const char*)g.A + (size_t)nxt.pm * tstep : cA; const char* nB = has_next ? (const char*)g.Bt + (size_t)nxt.pn * tstep : cB;
        for (int t = 0; t < nt; t += 2) {
            const bool last = (t == nt - 2);
            const char* a1 = cA + (size_t)(t + 1) * kstep;
            const char* a2 = last ? nA : cA + (size_t)(t + 2) * kstep; const char* b2 = last ? nB : cB + (size_t)(t + 2) * kstep;
            const char* a3 = a2 + kstep; const char* b3 = b2 + kstep;
            PG8_LDB(B0, 0, 0); PG8_SCHED; PG8_LDA(At, 0, 0);
            PG8_WAIT_L(8); PG8_BAR; PG8_WAIT_L(0); PG8_MMA(0, 0, At, B0); PG8_BAR; PG8_SCHED;
            PG8_LDB(B1, 0, 1); PG8_STAGE(PG8_SB(0, 0), b2, voffB);
            PG8_BAR; PG8_WAIT_L(0); PG8_MMA(0, 1, At, B1); PG8_BAR;
            PG8_LDA(At, 0, 1); PG8_STAGE(PG8_SA(0, 0), a2, voffA);
            PG8_BAR; PG8_WAIT_L(0); PG8_MMA(1, 0, At, B0); PG8_BAR; PG8_SCHED;
            PG8_STAGE(PG8_SB(0, 1), b2 + hstep, voffB);
            { const int pre_ = __builtin_amdgcn_readfirstlane((t == 0 && ui > 0) ? 1 : 0);
              asm volatile("s_cmp_eq_u32 %0, 0\n\ts_cbranch_scc1 2\n\ts_waitcnt vmcnt(22)\n\ts_branch 1\n\ts_waitcnt vmcnt(6)" :: "s"(pre_) : "memory", "scc"); }
            PG8_BAR; PG8_MMA(1, 1, At, B1); PG8_BAR;
            PG8_LDB(B0, 1, 0); PG8_SCHED; PG8_LDA(At, 1, 0); PG8_STAGE(PG8_SA(0, 1), a2 + hstep, voffA);
            PG8_WAIT_L(8); PG8_BAR; PG8_WAIT_L(0); PG8_MMA(0, 0, At, B0); PG8_BAR; PG8_SCHED;
            PG8_LDB(B1, 1, 1); PG8_STAGE(PG8_SB(1, 0), b3, voffB);
            PG8_BAR; PG8_WAIT_L(0); PG8_MMA(0, 1, At, B1); PG8_BAR;
            PG8_LDA(At, 1, 1); PG8_STAGE(PG8_SA(1, 0), a3, voffA);
            PG8_BAR; PG8_WAIT_L(0); PG8_MMA(1, 0, At, B0); PG8_BAR; PG8_SCHED;
            PG8_STAGE(PG8_SB(1, 1), b3 + hstep, voffB);
            PG8_WAIT_V(6); PG8_BAR; PG8_MMA(1, 1, At, B1); PG8_BAR;
            PG8_STAGE(PG8_SA(1, 1), a3 + hstep, voffA);
        }
        E(acc, cur, wr, wc, fr, fq, ldx, ui & 1);
        if (!has_next) break;
#pragma unroll
        for (int a = 0; a < 2; ++a)
#pragma unroll
            for (int b = 0; b < 2; ++b)
#pragma unroll
                for (int m = 0; m < 4; ++m)
#pragma unroll
                    for (int n = 0; n < 2; ++n) acc[a][b][m][n] = (f32x4){0.f, 0.f, 0.f, 0.f};
        cur = nxt; cA = nA; cB = nB; ++ui;
        E.prefetch(ldx, cur, ui & 1, wid, lane);
    }
    PG8_WAIT_V(0);
    if (wr == 0) PG8_BAR;
    PG8_BAR;
#undef PG8_SA
#undef PG8_SB
#undef PG8_STAGE
#undef PG8_LDA
#undef PG8_LDB
#undef PG8_MMA
#undef PG8_WAIT_V
#undef PG8_WAIT_L
#undef PG8_BAR
#undef PG8_SCHED
}
}


struct EpiProj {
    static constexpr bool PERM = true;
    bf16_t* O; const bf16_t* SS;
    __device__ __forceinline__ void prefetch(LAS unsigned char* ldx, const pg8::Unit& u, int par, int wid, int lane) const { prefetch_ss(SS, ldx, u.pm, par, wid, lane); }
    __device__ __forceinline__ void operator()(const f32x4 (&acc)[2][2][4][2], const pg8::Unit& u, int wr, int wc, int fr_, int fq_, LAS unsigned char* ldx, int par) const {
        int ln_ = fr_ | (fq_ << 4); asm volatile("" : "+v"(ln_)); const int fr = ln_ & 15, fq = ln_ >> 4;
        const int pn = u.pn;
        const int mode = (pn < 2) ? 1 : (pn == 2) ? 0 : (pn < 5) ? 2 : (pn < 7) ? 3 : (pn < 9) ? 0 : 4;
        const int row0 = u.pm * 256 + wr * 64 + fr;
        f32x2 invr[2];
#pragma unroll
        for (int j = 0; j < 4; ++j) { const float dp = (float)(16 * (wc & 1) + 4 * fq + j); const float v = exp2f(-dp * 0.41524101186092034f) * 0.15915494309189535f; if (j & 1) invr[j >> 1].y = v; else invr[j >> 1].x = v; }
#pragma unroll
        for (int ai = 0; ai < 2; ++ai)
#pragma unroll
            for (int m = 0; m < 4; ++m) {
                const int row = row0 + ai * 128 + m * 16;
                const float rs = rstd_row_lds(ldx + LDSX_SS + par * 8192, ai * 128 + wr * 64 + m * 16 + fr, fq);
                bf16_t* rowp = O + (size_t)row * NIN + pn * 256 + wc * 32 + fq * 8;
                if (mode == 2 || mode == 3) {
                    const float pos = (float)(row & (SEQL - 1));
                    const float sc = ((mode == 2) ? 0.125f : 1.0f) * rs;
                    f32x2 cs[2], sn[2];
#pragma unroll
                    for (int jp = 0; jp < 2; ++jp) {
                        f32x2 rev = invr[jp] * pos; rev.x -= floorf(rev.x); rev.y -= floorf(rev.y);
                        cs[jp].x = __builtin_amdgcn_cosf(rev.x) * sc; cs[jp].y = __builtin_amdgcn_cosf(rev.y) * sc;
                        sn[jp].x = __builtin_amdgcn_sinf(rev.x) * sc; sn[jp].y = __builtin_amdgcn_sinf(rev.y) * sc;
                    }
#pragma unroll
                    for (int bj = 0; bj < 2; ++bj) {
                        const f32x4 x1 = acc[ai][bj][m][0], x2 = acc[ai][bj][m][1];
                        const f32x2 a0 = x1.xy * cs[0] - x2.xy * sn[0], a1 = x1.zw * cs[1] - x2.zw * sn[1];
                        const f32x2 b0 = x2.xy * cs[0] + x1.xy * sn[0], b1 = x2.zw * cs[1] + x1.zw * sn[1];
                        u32x4 w; w.x = pk2(a0.x, a0.y); w.y = pk2(a1.x, a1.y); w.z = pk2(b0.x, b0.y); w.w = pk2(b1.x, b1.y);
                        *(u32x4*)(rowp + bj * 128) = w;
                    }
                } else {
#pragma unroll
                    for (int bj = 0; bj < 2; ++bj) {
                        f32x2 v[4];
                        v[0] = acc[ai][bj][m][0].xy * rs; v[1] = acc[ai][bj][m][0].zw * rs; v[2] = acc[ai][bj][m][1].xy * rs; v[3] = acc[ai][bj][m][1].zw * rs;
                        if (mode == 1) {
#pragma unroll
                            for (int i = 0; i < 4; ++i) {
                                const f32x2 x = v[i], t = x * x;
                                const f32x2 ar = x * (t * (-2.3022082f * 0.044715f) + (-2.3022082f));
                                f32x2 e; e.x = __builtin_amdgcn_exp2f(ar.x); e.y = __builtin_amdgcn_exp2f(ar.y);
                                const f32x2 d = e + 1.0f; f32x2 r; r.x = __builtin_amdgcn_rcpf(d.x); r.y = __builtin_amdgcn_rcpf(d.y);
                                v[i] = x * r;
                            }
                        } else if (mode == 4) {
#pragma unroll
                            for (int i = 0; i < 4; ++i) v[i] = silu2(v[i]);
                        }
                        u32x4 w; w.x = pk2(v[0].x, v[0].y); w.y = pk2(v[1].x, v[1].y); w.z = pk2(v[2].x, v[2].y); w.w = pk2(v[3].x, v[3].y);
                        *(u32x4*)(rowp + bj * 128) = w;
                    }
                }
            }
    }
};

struct EpiRes {
    static constexpr bool PERM = true;
    bf16_t* XB; bf16_t* SSo;
    __device__ __forceinline__ void prefetch(LAS unsigned char*, const pg8::Unit&, int, int, int) const {}
    __device__ __forceinline__ void operator()(const f32x4 (&acc)[2][2][4][2], const pg8::Unit& u, int wr, int wc, int fr_, int fq_, LAS unsigned char*, int) const {
        int ln_ = fr_ | (fq_ << 4); asm volatile("" : "+v"(ln_)); const int fr = ln_ & 15, fq = ln_ >> 4;
        const int row0 = u.pm * 256 + wr * 64 + fr, col0 = u.pn * 256 + wc * 32 + fq * 8;
        u32x4 res[2][4][2];
#pragma unroll
        for (int ai = 0; ai < 2; ++ai)
#pragma unroll
            for (int m = 0; m < 4; ++m)
#pragma unroll
                for (int bj = 0; bj < 2; ++bj) res[ai][m][bj] = *(const u32x4*)(XB + (unsigned)(row0 + ai * 128 + m * 16) * (unsigned)DM + col0 + bj * 128);
#pragma unroll
        for (int ai = 0; ai < 2; ++ai)
#pragma unroll
            for (int m = 0; m < 4; ++m) {
                const int row = row0 + ai * 128 + m * 16;
                float ssq = 0.f;
#pragma unroll
                for (int bj = 0; bj < 2; ++bj) {
                    const unsigned idx = (unsigned)row * (unsigned)DM + col0 + bj * 128;
                    const u32x4 r = res[ai][m][bj];
                    const f32x4 a0 = acc[ai][bj][m][0], a1 = acc[ai][bj][m][1];
                    const float o0 = a0[0] + bflo(r.x), o1 = a0[1] + bfhi(r.x), o2 = a0[2] + bflo(r.y), o3 = a0[3] + bfhi(r.y);
                    const float o4 = a1[0] + bflo(r.z), o5 = a1[1] + bfhi(r.z), o6 = a1[2] + bflo(r.w), o7 = a1[3] + bfhi(r.w);
                    u32x4 w; w.x = pk2(o0, o1); w.y = pk2(o2, o3); w.z = pk2(o4, o5); w.w = pk2(o6, o7);
                    *(u32x4*)(XB + idx) = w;
                    ssq += (o0 * o0 + o1 * o1) + (o2 * o2 + o3 * o3) + (o4 * o4 + o5 * o5) + (o6 * o6 + o7 * o7);
                }
                ssq += __shfl_xor(ssq, 16);
                ssq += __shfl_xor(ssq, 32);
                if (fq == 0) SSo[(size_t)row * 16 + u.pn * 4 + wc] = f2bf(ssq);
            }
    }
};

struct EpiUp {
    static constexpr bool PERM = true;
    unsigned char* wsb; const float* cw; const float* cb;
    __device__ __forceinline__ void prefetch(LAS unsigned char* ldx, const pg8::Unit& u, int par, int wid, int lane) const {
        prefetch_ss((const bf16_t*)(wsb + WS_SS), ldx, u.pm, par, wid, lane);
        const int pr = lane >> 4, half = (lane >> 3) & 1, c4 = (lane & 7) * 4;
        const float* src = (pr < 3 ? cw + pr * NUP : cb) + half * DFF + u.pn * 128 + (wid & 3) * 32 + c4;
        __builtin_amdgcn_global_load_lds((const unsigned*)src, (LAS unsigned*)(ldx + LDSX_W + wid * 1024), 16, 0, 0);
    }
    __device__ __forceinline__ void operator()(f32x4 (&acc)[2][2][4][2], const pg8::Unit& u, int wr, int wc, int fr_, int fq_, LAS unsigned char* ldx, int par) const {
        int ln_ = fr_ | (fq_ << 4); asm volatile("" : "+v"(ln_)); const int fr = ln_ & 15, fq = ln_ >> 4;
        const int row0 = u.pm * 256 + wr * 64 + fr;
        const int ct = wc * 32 + fq * 8;
        bf16_t* ACT = (bf16_t*)(wsb + WS_PROJ); bf16_t* HALO = (bf16_t*)(wsb + WS_HALO);
        LAS float* wl = (LAS float*)(ldx + LDSX_W + (wr * 4 + wc) * 1024);
        {
            const LAS unsigned char* ssl = ldx + LDSX_SS + par * 8192;
#pragma unroll
            for (int ai = 0; ai < 2; ++ai)
#pragma unroll
                for (int m = 0; m < 4; ++m) {
                    const float r = rstd_row_lds(ssl, ai * 128 + wr * 64 + m * 16 + fr, fq);
#pragma unroll
                    for (int bj = 0; bj < 2; ++bj)
#pragma unroll
                        for (int n = 0; n < 2; ++n) acc[ai][bj][m][n] = acc[ai][bj][m][n] * r;
                }
        }
        if (fr < 2 || fr >= 14) {
            const int slot = (fr < 2) ? fr : fr - 12;
#pragma unroll
            for (int ai = 0; ai < 2; ++ai) {
                const int strip = u.pm * 4 + ai * 2 + wr;
                bf16_t* hp = HALO + ((size_t)strip * 4 + slot) * NUP + u.pn * 256 + ct;
#pragma unroll
                for (int bj = 0; bj < 2; ++bj) {
                    const f32x4 a0 = (fr < 2) ? acc[ai][bj][0][0] : acc[ai][bj][3][0];
                    const f32x4 a1 = (fr < 2) ? acc[ai][bj][0][1] : acc[ai][bj][3][1];
                    u32x4 w; w.x = pk2(a0[0], a0[1]); w.y = pk2(a0[2], a0[3]); w.z = pk2(a1[0], a1[1]); w.w = pk2(a1[2], a1[3]);
                    *(u32x4*)(hp + bj * 128) = w;
                }
            }
        }
        __builtin_amdgcn_sched_barrier(0);
        const bool ge1 = fr >= 1, ge2 = fr >= 2;
#pragma unroll
        for (int n = 0; n < 2; ++n) {
            const unsigned colg = u.pn * 128 + ct + n * 4;
            const int lc = fq * 8 + n * 4;
#pragma unroll
            for (int ai = 0; ai < 2; ++ai) {
                asm volatile("" ::: "memory"); __builtin_amdgcn_sched_barrier(0);
                f32x2 sg[4][2];
                {
                    const f32x4 w0 = *(const LAS f32x4*)(wl + 0 * 64 + lc), w1 = *(const LAS f32x4*)(wl + 1 * 64 + lc), w2 = *(const LAS f32x4*)(wl + 2 * 64 + lc), wb = *(const LAS f32x4*)(wl + 3 * 64 + lc);
#pragma unroll
                    for (int jp = 0; jp < 2; ++jp) {
                        const f32x2 a0 = jp ? w0.zw : w0.xy, a1 = jp ? w1.zw : w1.xy, a2 = jp ? w2.zw : w2.xy, ab = jp ? wb.zw : wb.xy;
                        f32x2 r1 = {0.f, 0.f}, r2 = {0.f, 0.f};
#pragma unroll
                        for (int m = 0; m < 4; ++m) {
                            const f32x2 x = jp ? acc[ai][0][m][n].zw : acc[ai][0][m][n].xy;
                            f32x2 n1, n2, p1, p2;
                            n1.x = ror1(x.x); n1.y = ror1(x.y); n2.x = ror2(x.x); n2.y = ror2(x.y);
                            p1.x = ge1 ? n1.x : r1.x; p1.y = ge1 ? n1.y : r1.y; p2.x = ge2 ? n2.x : r2.x; p2.y = ge2 ? n2.y : r2.y;
                            sg[m][jp] = silu2(ab + a0 * p2 + a1 * p1 + a2 * x);
                            r1 = n1; r2 = n2;
                        }
                    }
                }
                __builtin_amdgcn_sched_barrier(0);
                {
                    const f32x4 w0 = *(const LAS f32x4*)(wl + 0 * 64 + 32 + lc), w1 = *(const LAS f32x4*)(wl + 1 * 64 + 32 + lc), w2 = *(const LAS f32x4*)(wl + 2 * 64 + 32 + lc), wb = *(const LAS f32x4*)(wl + 3 * 64 + 32 + lc);
                    unsigned ow[4][2];
#pragma unroll
                    for (int jp = 0; jp < 2; ++jp) {
                        const f32x2 a0 = jp ? w0.zw : w0.xy, a1 = jp ? w1.zw : w1.xy, a2 = jp ? w2.zw : w2.xy, ab = jp ? wb.zw : wb.xy;
                        f32x2 r1 = {0.f, 0.f}, r2 = {0.f, 0.f};
#pragma unroll
                        for (int m = 0; m < 4; ++m) {
                            const f32x2 x = jp ? acc[ai][1][m][n].zw : acc[ai][1][m][n].xy;
                            f32x2 n1, n2, p1, p2;
                            n1.x = ror1(x.x); n1.y = ror1(x.y); n2.x = ror2(x.x); n2.y = ror2(x.y);
                            p1.x = ge1 ? n1.x : r1.x; p1.y = ge1 ? n1.y : r1.y; p2.x = ge2 ? n2.x : r2.x; p2.y = ge2 ? n2.y : r2.y;
                            const f32x2 o = sg[m][jp] * (ab + a0 * p2 + a1 * p1 + a2 * x);
                            ow[m][jp] = pk2(o.x, o.y);
                            r1 = n1; r2 = n2;
                        }
                    }
#pragma unroll
                    for (int m = 0; m < 4; ++m) {
                        u32x2 w; w.x = ow[m][0]; w.y = ow[m][1];
                        const unsigned off = (unsigned)(row0 + ai * 128 + m * 16) * (unsigned)DFF + colg;
                        *(u32x2*)(ACT + off) = w;
                    }
                }
            }
        }
    }
};

__device__ __forceinline__ int win_cmap(int r) {
    if (r >= PC_Q && r < PC_VV) { const int p = r & 63, w = p >> 5, q = (p >> 3) & 3, n = (p >> 2) & 1, j = p & 3; return (r & ~63) + 16 * w + 4 * q + j + 32 * n; }
    return r;
}
__device__ __forceinline__ int wup_cmap(int r) { const int pn = r >> 8, ct = r & 255; return (ct < 128) ? pn * 128 + ct : DFF + pn * 128 + (ct - 128); }

__device__ __forceinline__ void wconv_tile(float* T, const float* src, int N, int K, bf16_t* dst, int kt, int rt, int mapmode, const float* gs, int tid) {
    const int rr = tid & 255, k0 = kt * 64, kh = tid >> 8;
    const int r = rt * 256 + rr;
    const int c = (mapmode == 1) ? win_cmap(r) : (mapmode == 2) ? wup_cmap(r) : r;
    float v[32];
#pragma unroll
    for (int i = 0; i < 32; ++i) v[i] = src[(size_t)(k0 + i * 2 + kh) * N + c];
    if (gs) {
#pragma unroll
        for (int i = 0; i < 32; ++i) v[i] *= gs[k0 + i * 2 + kh];
    }
#pragma unroll
    for (int i = 0; i < 32; ++i) T[(i * 2 + kh) * 257 + rr] = v[i];
    __syncthreads();
#pragma unroll
    for (int ps = 0; ps < 4; ++ps) {
        const int r2 = (tid >> 3) + ps * 64, kc = tid & 7;
        float f[8];
#pragma unroll
        for (int i = 0; i < 8; ++i) f[i] = T[(kc * 8 + i) * 257 + r2];
        u32x4 w; w.x = pk2(f[0], f[1]); w.y = pk2(f[2], f[3]); w.z = pk2(f[4], f[5]); w.w = pk2(f[6], f[7]);
        *(u32x4*)(dst + (size_t)(rt * 256 + r2) * K + k0 + kc * 8) = w;
    }
    __syncthreads();
}

__device__ __forceinline__ void wconv_job(float* T, unsigned char* ws, const float* w_in, const float* w_out, const float* w_up, const float* w_down, const float* n1g, const float* n2g, int l, int t, int tid) {
    if (t < 176) { wconv_tile(T, w_in + (size_t)l * DM * NIN, NIN, DM, (bf16_t*)(ws + WS_WIN) + (size_t)l * NIN * DM, t % 16, t / 16, 1, n1g + l * DM, tid); }
    else if (t < 240) { t -= 176; wconv_tile(T, w_out + (size_t)l * DM * DM, DM, DM, (bf16_t*)(ws + WS_WOUT) + (size_t)l * DM * DM, t % 16, t / 16, 0, nullptr, tid); }
    else if (t < 592) { t -= 240; wconv_tile(T, w_up + (size_t)l * DM * NUP, NUP, DM, (bf16_t*)(ws + WS_WUP) + (size_t)l * NUP * DM, t % 16, t / 16, 2, n2g + l * DM, tid); }
    else { t -= 592; wconv_tile(T, w_down + (size_t)l * DFF * DM, DM, DFF, (bf16_t*)(ws + WS_WDN) + (size_t)l * DM * DFF, t % 44, t / 44, 0, nullptr, tid); }
}

__device__ __forceinline__ void phase_prologue(const Params& p, unsigned char* lds) {
    unsigned char* ws = p.ws;
    float* T = (float*)lds;
    int tid = threadIdx.x; asm volatile("" : "+v"(tid));
    const int G = gridDim.x, bid = blockIdx.x;
    {
        const int nl = (G == 256) ? 1 : NLAYER;
        for (int job = bid; job < nl * 768; job += G) wconv_job(T, ws, p.w_in, p.w_out, p.w_up, p.w_down, p.norm1_g, p.norm2_g, job / 768, job % 768, tid);
    }
    {
        bf16_t* AWS = (bf16_t*)(ws + WS_AWS); bf16_t* BWT = (bf16_t*)(ws + WS_BWT);
        for (int i = bid * NTHR + tid; i < NLAYER * 4 * 128 * 128; i += G * NTHR) {
            const int s = i & 127, t = (i >> 7) & 127;
            const float v = ((t >> 6) >= (s >> 6)) ? p.a_ws[i] : 0.f;
            AWS[i] = f2bf(v);
        }
        for (int i = bid * NTHR + tid; i < NLAYER * 4 * 64 * 64; i += G * NTHR) {
            const int c = i & 63, d = (i >> 6) & 63, lg = i >> 12;
            BWT[i] = f2bf(p.b_w[(size_t)lg * 4096 + c * 64 + d]);
        }
    }
    {
        bf16_t* XB = (bf16_t*)(ws + WS_XB); bf16_t* SS = (bf16_t*)(ws + WS_SS);
        const int wave = tid >> 6, lane = tid & 63;
        const int rstride = G * 8;
        for (int row0 = bid * 8 + wave; row0 < MTOK; row0 += 8 * rstride) {
            f32x4 v[8][4];
#pragma unroll
            for (int r = 0; r < 8; ++r) {
                const int row = row0 + r * rstride;
                if (row < MTOK) {
#pragma unroll
                    for (int i = 0; i < 2; ++i) { v[r][2 * i] = *(const f32x4*)(p.x + (size_t)row * DM + i * 512 + lane * 8); v[r][2 * i + 1] = *(const f32x4*)(p.x + (size_t)row * DM + i * 512 + lane * 8 + 4); }
                }
            }
#pragma unroll
            for (int r = 0; r < 8; ++r) {
                const int row = row0 + r * rstride;
                if (row < MTOK) {
                    float ss = 0.f;
#pragma unroll
                    for (int i = 0; i < 2; ++i) {
                        const f32x4 q0 = v[r][2 * i], q1 = v[r][2 * i + 1];
                        ss += (q0[0] * q0[0] + q0[1] * q0[1]) + (q0[2] * q0[2] + q0[3] * q0[3]) + (q1[0] * q1[0] + q1[1] * q1[1]) + (q1[2] * q1[2] + q1[3] * q1[3]);
                        u32x4 w; w.x = pk2(q0[0], q0[1]); w.y = pk2(q0[2], q0[3]); w.z = pk2(q1[0], q1[1]); w.w = pk2(q1[2], q1[3]);
                        *(u32x4*)(XB + (size_t)row * DM + i * 512 + lane * 8) = w;
                    }
#pragma unroll
                    for (int o = 32; o >= 1; o >>= 1) ss += __shfl_xor(ss, o);
                    if (lane < 16) SS[(size_t)row * 16 + lane] = (lane == 0) ? f2bf(ss) : (bf16_t)0;
                }
            }
        }
    }
}

__device__ __forceinline__ void stage_kv(bf16_t* kS, bf16_t* vS, const bf16_t* PROJ, int row0, int h, int lane, float l2g, int e0, bool do_k) {
    const int r = lane >> 3, pc = (lane & 7) * 8;
    const bf16_t* rp = PROJ + (size_t)(row0 + r) * NIN + h * 64 + pc;
    u32x4 kr[8], vr[8];
    if (do_k) {
#pragma unroll
        for (int i = 0; i < 8; ++i) kr[i] = *(const u32x4*)(rp + (size_t)(8 * i) * NIN + PC_K);
    }
#pragma unroll
    for (int i = 0; i < 8; ++i) vr[i] = *(const u32x4*)(rp + (size_t)(8 * i) * NIN + PC_VV);
    if (do_k) {
        float f = exp2f(l2g * (float)(e0 - r));
        const float st = exp2f(-8.0f * l2g);
#pragma unroll
        for (int i = 0; i < 8; ++i) {
            u32x4 w;
            w.x = pk2(bflo(kr[i].x) * f, bfhi(kr[i].x) * f); w.y = pk2(bflo(kr[i].y) * f, bfhi(kr[i].y) * f);
            w.z = pk2(bflo(kr[i].z) * f, bfhi(kr[i].z) * f); w.w = pk2(bflo(kr[i].w) * f, bfhi(kr[i].w) * f);
            *(u32x4*)(kS + (r + 8 * i) * 72 + pc) = w;
            f *= st;
        }
    }
#pragma unroll
    for (int i = 0; i < 8; ++i) *(u32x4*)(vS + (r + 8 * i) * 72 + pc) = vr[i];
}

typedef short s16x4 __attribute__((ext_vector_type(4)));
__device__ __forceinline__ bf16x8 tr_frag(const bf16_t* X, int ld, int krow0, int krow1, int idx0, int fr) {
    const int q = fr >> 2, p4 = (fr & 3) * 4;
    const s16x4 lo = __builtin_amdgcn_ds_read_tr16_b64_v4i16((LAS s16x4*)(X + (krow0 + q) * ld + idx0 + p4));
    const s16x4 hi = __builtin_amdgcn_ds_read_tr16_b64_v4i16((LAS s16x4*)(X + (krow1 + q) * ld + idx0 + p4));
    bf16x8 r; r[0] = lo[0]; r[1] = lo[1]; r[2] = lo[2]; r[3] = lo[3]; r[4] = hi[0]; r[5] = hi[1]; r[6] = hi[2]; r[7] = hi[3];
    return r;
}
#define MFMA16(a, b, c) __builtin_amdgcn_mfma_f32_16x16x32_bf16((a), (b), (c), 0, 0, 0)

__device__ __forceinline__ void phase_mix1(const PT& p, unsigned char* lds, int l) {
    unsigned char* ws = p.ws();
    const float* a_vnorm_g_ = p.a_vnorm_g(); const float* a_bs_ = p.a_bs(); const float* b_scale_ = p.b_scale();
    const bf16_t* PROJ = (const bf16_t*)(ws + WS_PROJ); bf16_t* Y = (bf16_t*)(ws + WS_Y); unsigned* KVS = (unsigned*)(ws + WS_KVS);
    const bf16_t* AWS = (const bf16_t*)(ws + WS_AWS); const bf16_t* BWT = (const bf16_t*)(ws + WS_BWT);
    int tid = threadIdx.x; asm volatile("" : "+v"(tid));
    int bid_ = blockIdx.x, G_ = gridDim.x; asm volatile("" : "+s"(bid_), "+s"(G_));
    const int wave = __builtin_amdgcn_readfirstlane(tid >> 6), lane = tid & 63, fr = lane & 15, fq = lane >> 4;
#pragma unroll 1
    for (int u = bid_; u < MTOK / 128; u += G_) {
        const int R0 = u * 128;
        __syncthreads();
        {
            bf16_t* vnS = (bf16_t*)lds;
            const int rr = tid >> 5, pc = (tid & 31) * 8;
            const bf16_t* src = PROJ + (size_t)(R0 + rr) * NIN + PC_V + pc;
            u32x4 raw[8];
#pragma unroll
            for (int i = 0; i < 8; ++i) raw[i] = *(const u32x4*)(src + (size_t)(16 * i) * NIN);
            f32x4 ga0 = *(const f32x4*)(a_vnorm_g_ + l * 256 + pc), ga1 = *(const f32x4*)(a_vnorm_g_ + l * 256 + pc + 4);
#pragma unroll
            for (int i = 0; i < 8; ++i) {
                const float a0 = bflo(raw[i].x), a1 = bfhi(raw[i].x), a2 = bflo(raw[i].y), a3 = bfhi(raw[i].y), a4 = bflo(raw[i].z), a5 = bfhi(raw[i].z), a6 = bflo(raw[i].w), a7 = bfhi(raw[i].w);
                float ss = (a0 * a0 + a1 * a1) + (a2 * a2 + a3 * a3) + (a4 * a4 + a5 * a5) + (a6 * a6 + a7 * a7);
                ss += __shfl_xor(ss, 1); ss += __shfl_xor(ss, 2); ss += __shfl_xor(ss, 4); ss += __shfl_xor(ss, 8); ss += __shfl_xor(ss, 16);
                const float rstd = rsqrtf(ss * (1.0f / 256.0f) + 1e-6f);
                u32x4 w;
                w.x = pk2(a0 * rstd * ga0[0], a1 * rstd * ga0[1]); w.y = pk2(a2 * rstd * ga0[2], a3 * rstd * ga0[3]);
                w.z = pk2(a4 * rstd * ga1[0], a5 * rstd * ga1[1]); w.w = pk2(a6 * rstd * ga1[2], a7 * rstd * ga1[3]);
                *(u32x4*)(vnS + (rr + 16 * i) * 264 + pc) = w;
            }
            __syncthreads();
            const int h = wave >> 1, mh = wave & 1, kmax = mh ? 4 : 2;
            const bf16_t* Wa = AWS + (size_t)(l * 4 + h) * 128 * 128;
            const float* bs = a_bs_ + (l * 4 + h) * 128;
#pragma unroll 1
            for (int mt = 0; mt < 4; ++mt) {
                const int t0 = mh * 64 + mt * 16;
                const size_t rowi = (size_t)(R0 + t0 + fr);
                bf16x8 wf[4];
#pragma unroll
                for (int ks = 0; ks < 4; ++ks) wf[ks] = *(const bf16x8*)(Wa + (t0 + fr) * 128 + ks * 32 + fq * 8);
                u32x2 uu[4];
#pragma unroll
                for (int nt = 0; nt < 4; ++nt) uu[nt] = *(const u32x2*)(PROJ + rowi * NIN + PC_U + h * 64 + nt * 16 + fq * 4);
                const float bsv = bs[t0 + fr];
                f32x4 acc[4];
#pragma unroll
                for (int nt = 0; nt < 4; ++nt) acc[nt] = (f32x4){0.f, 0.f, 0.f, 0.f};
#pragma unroll
                for (int ks = 0; ks < 4; ++ks) {
                    if (ks < kmax) {
#pragma unroll
                        for (int nt = 0; nt < 4; ++nt) {
                            const bf16x8 vv = tr_frag(vnS, 264, ks * 32 + fq * 8, ks * 32 + fq * 8 + 4, h * 64 + nt * 16, fr);
                            acc[nt] = MFMA16(vv, wf[ks], acc[nt]);
                        }
                    }
                }
#pragma unroll
                for (int nt = 0; nt < 4; ++nt) {
                    u32x2 w;
                    w.x = pk2(bflo(uu[nt].x) * (acc[nt][0] + bsv), bfhi(uu[nt].x) * (acc[nt][1] + bsv));
                    w.y = pk2(bflo(uu[nt].y) * (acc[nt][2] + bsv), bfhi(uu[nt].y) * (acc[nt][3] + bsv));
                    *(u32x2*)(Y + rowi * DM + h * 64 + nt * 16 + fq * 4) = w;
                }
            }
            __syncthreads();
        }
        {
            bf16_t* pooled = (bf16_t*)lds;
            {
                const int g8 = tid & 31, tseg = tid >> 5;
                const int ch0 = g8 * 8, win = 2 << (ch0 >> 6);
                const int tl0 = tseg * 8, pos0 = (u & 63) * 128 + tl0;
                const bf16_t* xp = PROJ + (size_t)(R0 + tl0) * NIN + PC_XB + ch0;
                float a8[8];
#pragma unroll
                for (int e = 0; e < 8; ++e) a8[e] = 0.f;
#pragma unroll
                for (int i = 1; i < 16; ++i) {
                    if (i < win && pos0 - i >= 0) {
                        const u32x4 r = *(const u32x4*)(xp - (ptrdiff_t)i * NIN);
                        a8[0] += bflo(r.x); a8[1] += bfhi(r.x); a8[2] += bflo(r.y); a8[3] += bfhi(r.y); a8[4] += bflo(r.z); a8[5] += bfhi(r.z); a8[6] += bflo(r.w); a8[7] += bfhi(r.w);
                    }
                }
#pragma unroll
                for (int r8 = 0; r8 < 8; ++r8) {
                    const u32x4 r = *(const u32x4*)(xp + (ptrdiff_t)r8 * NIN);
                    const float c0 = bflo(r.x), c1 = bfhi(r.x), c2 = bflo(r.y), c3 = bfhi(r.y), c4 = bflo(r.z), c5 = bfhi(r.z), c6 = bflo(r.w), c7 = bfhi(r.w);
                    a8[0] += c0; a8[1] += c1; a8[2] += c2; a8[3] += c3; a8[4] += c4; a8[5] += c5; a8[6] += c6; a8[7] += c7;
                    const int pos = pos0 + r8;
                    const float inv = 1.0f / (float)((pos + 1 < win) ? pos + 1 : win);
                    u32x4 w;
                    w.x = pk2(a8[0] * inv - c0, a8[1] * inv - c1); w.y = pk2(a8[2] * inv - c2, a8[3] * inv - c3);
                    w.z = pk2(a8[4] * inv - c4, a8[5] * inv - c5); w.w = pk2(a8[6] * inv - c6, a8[7] * inv - c7);
                    *(u32x4*)(pooled + (tl0 + r8) * 264 + ch0) = w;
                    const int o = r8 - win + 1;
                    if (pos0 + o >= 0) {
                        const u32x4 q = *(const u32x4*)(xp + (ptrdiff_t)o * NIN);
                        a8[0] -= bflo(q.x); a8[1] -= bfhi(q.x); a8[2] -= bflo(q.y); a8[3] -= bfhi(q.y); a8[4] -= bflo(q.z); a8[5] -= bfhi(q.z); a8[6] -= bflo(q.w); a8[7] -= bfhi(q.w);
                    }
                }
            }
            __syncthreads();
            const int g = wave >> 1, mh = wave & 1;
            const bf16_t* Wb = BWT + (size_t)(l * 4 + g) * 64 * 64;
            const float* bsc = b_scale_ + l * 256 + g * 64;
            f32x4 bsv[4];
#pragma unroll
            for (int nt = 0; nt < 4; ++nt) bsv[nt] = *(const f32x4*)(bsc + nt * 16 + fq * 4);
#pragma unroll 1
            for (int mt = 0; mt < 4; ++mt) {
                const int t0 = mh * 64 + mt * 16;
                f32x4 acc[4];
#pragma unroll
                for (int nt = 0; nt < 4; ++nt) acc[nt] = (f32x4){0.f, 0.f, 0.f, 0.f};
#pragma unroll
                for (int ks = 0; ks < 2; ++ks) {
                    const bf16x8 pf = *(const bf16x8*)(pooled + (t0 + fr) * 264 + g * 64 + ks * 32 + fq * 8);
#pragma unroll
                    for (int nt = 0; nt < 4; ++nt) {
                        const bf16x8 wv = *(const bf16x8*)(Wb + (nt * 16 + fr) * 64 + ks * 32 + fq * 8);
                        acc[nt] = MFMA16(wv, pf, acc[nt]);
                    }
                }
#pragma unroll
                for (int nt = 0; nt < 4; ++nt) {
                    const f32x4 o = acc[nt] * bsv[nt];
                    u32x2 w; w.x = pk2(o[0], o[1]); w.y = pk2(o[2], o[3]);
                    *(u32x2*)(Y + (size_t)(R0 + t0 + fr) * DM + 256 + g * 64 + nt * 16 + fq * 4) = w;
                }
            }
            __syncthreads();
        }
        {
            const int h = wave;
            bf16_t* kdT = (bf16_t*)(lds + wave * 18432); bf16_t* vT = kdT + 64 * 72;
            const float l2g = log2_gamma(h);
            f32x4 T[4][4];
#pragma unroll
            for (int a = 0; a < 4; ++a)
#pragma unroll
                for (int b = 0; b < 4; ++b) T[a][b] = (f32x4){0.f, 0.f, 0.f, 0.f};
#pragma unroll 1
            for (int nn = 0; nn < 2; ++nn) {
                const int n = 1 - nn;
                stage_kv(kdT, vT, PROJ, R0 + 64 * n, h, lane, l2g, 127 - 64 * n, true);
                asm volatile("s_waitcnt lgkmcnt(0)" ::: "memory");
#pragma unroll
                for (int ks = 0; ks < 2; ++ks) {
                    bf16x8 a[4], b[4];
#pragma unroll
                    for (int i = 0; i < 4; ++i) { a[i] = tr_frag(kdT, 72, ks * 32 + fq * 8, ks * 32 + fq * 8 + 4, i * 16, fr); b[i] = tr_frag(vT, 72, ks * 32 + fq * 8, ks * 32 + fq * 8 + 4, i * 16, fr); }
#pragma unroll
                    for (int md = 0; md < 4; ++md)
#pragma unroll
                        for (int ne = 0; ne < 4; ++ne) T[md][ne] = MFMA16(a[md], b[ne], T[md][ne]);
                }
                asm volatile("s_waitcnt lgkmcnt(0)" ::: "memory");
            }
            unsigned* dst = KVS + (size_t)(u * 8 + h) * 2048 + lane;
#pragma unroll
            for (int md = 0; md < 4; ++md)
#pragma unroll
                for (int ne = 0; ne < 4; ++ne)
#pragma unroll
                    for (int rp = 0; rp < 2; ++rp) dst[((md * 4 + ne) * 2 + rp) * 64] = pk2(T[md][ne][2 * rp], T[md][ne][2 * rp + 1]);
        }
    }
}

__device__ __forceinline__ void phase_scan(const PT& p) {
    unsigned* KVS = (unsigned*)(p.ws() + WS_KVS);
    int tid = threadIdx.x; asm volatile("" : "+v"(tid));
    int bid_ = blockIdx.x, G_ = gridDim.x; asm volatile("" : "+s"(bid_), "+s"(G_));
    for (int e = bid_ * NTHR + tid; e < 4 * 8 * 2048; e += G_ * NTHR) {
        const int b = e >> 14, h = (e >> 11) & 7, i = e & 2047;
        const float dec = exp2f(log2_gamma(h) * 128.0f);
        unsigned* base = KVS + ((size_t)(b * 64) * 8 + h) * 2048 + i;
        float s0 = 0.f, s1 = 0.f;
#pragma unroll 1
        for (int u0 = 0; u0 < 64; u0 += 32) {
            unsigned t[32];
#pragma unroll
            for (int j = 0; j < 32; ++j) t[j] = base[(size_t)(u0 + j) * 8 * 2048];
#pragma unroll
            for (int j = 0; j < 32; ++j) { base[(size_t)(u0 + j) * 8 * 2048] = pk2(s0, s1); s0 = s0 * dec + bflo(t[j]); s1 = s1 * dec + bfhi(t[j]); }
        }
    }
}

__device__ __forceinline__ void phase_mix3(const PT& p, unsigned char* lds, int l) {
    unsigned char* ws = p.ws();
    const bf16_t* PROJ = (const bf16_t*)(ws + WS_PROJ); bf16_t* Y = (bf16_t*)(ws + WS_Y); const unsigned* KVS = (const unsigned*)(ws + WS_KVS);
    int tid = threadIdx.x; asm volatile("" : "+v"(tid));
    int bid_ = blockIdx.x, G_ = gridDim.x; asm volatile("" : "+s"(bid_), "+s"(G_));
    const int wave = __builtin_amdgcn_readfirstlane(tid >> 6), lane = tid & 63, fr = lane & 15, fq = lane >> 4;
    const int h = wave;
    bf16_t* kdT = (bf16_t*)(lds + wave * 18432); bf16_t* vT = kdT + 64 * 72;
    const float l2g = log2_gamma(h);
    const float dec64 = exp2f(l2g * 64.0f);
    const bool cached = (G_ >= MTOK / 128);
    const float spre = cached ? dec64 * dec64 : dec64, spost = cached ? exp2f(-l2g * 64.0f) : 1.0f;
    const float lanep = exp2f(l2g * (float)(fr - 4 * fq)), lanem = exp2f(l2g * (float)(4 * fq - fr));
    const float cm1 = exp2f(-l2g), cm2 = exp2f(-2.0f * l2g), cm3 = exp2f(-3.0f * l2g), cp1 = exp2f(l2g), cp2 = exp2f(2.0f * l2g), cp3 = exp2f(3.0f * l2g);
    const float d16 = exp2f(l2g * 16.0f), d32 = exp2f(l2g * 32.0f), d48 = exp2f(l2g * 48.0f);
    const float* cg = p.c_norm_g() + l * 512 + h * 64;
#pragma unroll 1
    for (int u = bid_; u < MTOK / 128; u += G_) {
        f32x4 S[4][4];
        {
            const unsigned* src = KVS + (size_t)(u * 8 + h) * 2048 + lane;
#pragma unroll
            for (int md = 0; md < 4; ++md)
#pragma unroll
                for (int ne = 0; ne < 4; ++ne)
#pragma unroll
                    for (int rp = 0; rp < 2; ++rp) { const unsigned w = src[((md * 4 + ne) * 2 + rp) * 64]; S[md][ne][2 * rp] = bflo(w); S[md][ne][2 * rp + 1] = bfhi(w); }
        }
#pragma unroll 1
        for (int n = 0; n < 2; ++n) {
            const int R = u * 128 + n * 64;
            asm volatile("s_waitcnt lgkmcnt(0)" ::: "memory");
            if (!(cached && n == 0)) stage_kv(kdT, vT, PROJ, R, h, lane, l2g, 63, n == 0);
            asm volatile("s_waitcnt lgkmcnt(0)" ::: "memory");
            bf16x8 Sb[2][4];
#pragma unroll
            for (int ks = 0; ks < 2; ++ks)
#pragma unroll
                for (int ne = 0; ne < 4; ++ne) {
                    const f32x4 lo = S[2 * ks][ne], hi = S[2 * ks + 1][ne];
                    u32x4 w; w.x = pk2(lo[0], lo[1]); w.y = pk2(lo[2], lo[3]); w.z = pk2(hi[0], hi[1]); w.w = pk2(hi[2], hi[3]);
                    Sb[ks][ne] = __builtin_bit_cast(bf16x8, w);
                }
            bf16x8 kf[4][2];
#pragma unroll
            for (int ms = 0; ms < 4; ++ms)
#pragma unroll
                for (int ks = 0; ks < 2; ++ks) kf[ms][ks] = *(const bf16x8*)(PROJ + (size_t)(R + ms * 16 + fr) * NIN + PC_K + h * 64 + ks * 32 + fq * 8);
#pragma unroll 1
            for (int mt = 0; mt < 4; ++mt) {
                const size_t rowi = (size_t)(R + mt * 16 + fr);
                const bf16_t* qrow = PROJ + rowi * NIN + PC_Q + h * 64;
                u32x2 gate[4];
#pragma unroll
                for (int ne = 0; ne < 4; ++ne) gate[ne] = *(const u32x2*)(PROJ + rowi * NIN + PC_G + h * 64 + ne * 16 + fq * 4);
                f32x4 sc[4];
#pragma unroll
                for (int ms = 0; ms < 4; ++ms) sc[ms] = (f32x4){0.f, 0.f, 0.f, 0.f};
#pragma unroll
                for (int ks = 0; ks < 2; ++ks) {
                    const bf16x8 bq = *(const bf16x8*)(qrow + ks * 32 + fq * 8);
#pragma unroll
                    for (int ms = 0; ms < 4; ++ms) sc[ms] = MFMA16(kf[ms][ks], bq, sc[ms]);
                }
                bf16x8 Pf[2];
                {
#pragma unroll
                    for (int ms = 0; ms < 4; ++ms) {
                        if (ms == mt) {
#pragma unroll
                            for (int rg = 0; rg < 4; ++rg) { const int e = fr - 4 * fq - rg; sc[ms][rg] *= __builtin_amdgcn_exp2f(l2g * (float)(e < 0 ? -e : e)); }
                        } else {
                            const int dk = (ms < mt) ? (mt - ms) : (ms - mt);
                            const float f = ((ms < mt) ? lanep : lanem) * ((dk == 1) ? d16 : (dk == 2) ? d32 : d48);
                            if (ms < mt) { sc[ms][0] *= f; sc[ms][1] *= f * cm1; sc[ms][2] *= f * cm2; sc[ms][3] *= f * cm3; }
                            else         { sc[ms][0] *= f; sc[ms][1] *= f * cp1; sc[ms][2] *= f * cp2; sc[ms][3] *= f * cp3; }
                        }
                    }
#pragma unroll
                    for (int ks = 0; ks < 2; ++ks) {
                        const f32x4 lo = sc[2 * ks], hi = sc[2 * ks + 1];
                        u32x4 w; w.x = pk2(lo[0], lo[1]); w.y = pk2(lo[2], lo[3]); w.z = pk2(hi[0], hi[1]); w.w = pk2(hi[2], hi[3]);
                        Pf[ks] = __builtin_bit_cast(bf16x8, w);
                    }
                }
                f32x4 yi[4], yc[4];
#pragma unroll
                for (int ne = 0; ne < 4; ++ne) { yi[ne] = (f32x4){0.f, 0.f, 0.f, 0.f}; yc[ne] = (f32x4){0.f, 0.f, 0.f, 0.f}; }
#pragma unroll
                for (int ks = 0; ks < 2; ++ks) {
                    const u32x2 q0 = *(const u32x2*)(qrow + ks * 32 + fq * 4), q1 = *(const u32x2*)(qrow + ks * 32 + 16 + fq * 4);
                    u32x4 qa; qa.x = q0.x; qa.y = q0.y; qa.z = q1.x; qa.w = q1.y;
                    const bf16x8 aq = __builtin_bit_cast(bf16x8, qa);
#pragma unroll
                    for (int ne = 0; ne < 4; ++ne) {
                        const bf16x8 vb = tr_frag(vT, 72, ks * 32 + fq * 4, ks * 32 + 16 + fq * 4, ne * 16, fr);
                        yi[ne] = MFMA16(vb, Pf[ks], yi[ne]);
                        yc[ne] = MFMA16(Sb[ks][ne], aq, yc[ne]);
                    }
                }
                {
                    const float qd = __builtin_amdgcn_exp2f(l2g * (float)(mt * 16 + fr + 1));
                    float s1 = 0.f;
#pragma unroll
                    for (int ne = 0; ne < 4; ++ne) { yi[ne] = yi[ne] + yc[ne] * qd; s1 += (yi[ne][0] + yi[ne][1]) + (yi[ne][2] + yi[ne][3]); }
                    s1 += __shfl_xor(s1, 16); s1 += __shfl_xor(s1, 32);
                    const float mu = s1 * (1.0f / 64.0f);
                    float s2 = 0.f;
#pragma unroll
                    for (int ne = 0; ne < 4; ++ne) { yi[ne] = yi[ne] - mu; s2 += (yi[ne][0] * yi[ne][0] + yi[ne][1] * yi[ne][1]) + (yi[ne][2] * yi[ne][2] + yi[ne][3] * yi[ne][3]); }
                    s2 += __shfl_xor(s2, 16); s2 += __shfl_xor(s2, 32);
                    const float rstd = rsqrtf(s2 * (1.0f / 64.0f) + 1e-6f);
#pragma unroll
                    for (int ne = 0; ne < 4; ++ne) {
                        const f32x4 cgv = *(const f32x4*)(cg + ne * 16 + fq * 4);
                        const f32x4 o = yi[ne] * rstd * cgv;
                        u32x2 w;
                        w.x = pk2(bflo(gate[ne].x) * o[0], bfhi(gate[ne].x) * o[1]);
                        w.y = pk2(bflo(gate[ne].y) * o[2], bfhi(gate[ne].y) * o[3]);
                        *(u32x2*)(Y + rowi * DM + 512 + h * 64 + ne * 16 + fq * 4) = w;
                    }
                }
            }
            if (n == 0) {
#pragma unroll
                for (int md = 0; md < 4; ++md)
#pragma unroll
                    for (int ne = 0; ne < 4; ++ne) S[md][ne] = S[md][ne] * spre;
#pragma unroll
                for (int ks = 0; ks < 2; ++ks) {
                    bf16x8 a[4], b[4];
#pragma unroll
                    for (int i = 0; i < 4; ++i) { a[i] = tr_frag(kdT, 72, ks * 32 + fq * 8, ks * 32 + fq * 8 + 4, i * 16, fr); b[i] = tr_frag(vT, 72, ks * 32 + fq * 8, ks * 32 + fq * 8 + 4, i * 16, fr); }
#pragma unroll
                    for (int md = 0; md < 4; ++md)
#pragma unroll
                        for (int ne = 0; ne < 4; ++ne) S[md][ne] = MFMA16(a[md], b[ne], S[md][ne]);
                }
#pragma unroll
                for (int md = 0; md < 4; ++md)
#pragma unroll
                    for (int ne = 0; ne < 4; ++ne) S[md][ne] = S[md][ne] * spost;
            }
        }
    }
}

__device__ __forceinline__ void phase_fixup(const PT& p, int l) {
    int tid = threadIdx.x; asm volatile("" : "+v"(tid));
    int bid_ = blockIdx.x, G_ = gridDim.x; asm volatile("" : "+s"(bid_), "+s"(G_));
    unsigned char* ws = p.ws(); const bf16_t* HALO = (const bf16_t*)(ws + WS_HALO); bf16_t* ACT = (bf16_t*)(ws + WS_PROJ);
    const float* cw = p.conv_w() + (size_t)l * 3 * NUP; const float* cb = p.conv_b() + (size_t)l * NUP;
    const f32x4 z = {0.f, 0.f, 0.f, 0.f};
#define HLD(ptr) ({ const u32x2 q_ = *(const u32x2*)(ptr); f32x4 r_; r_[0] = bflo(q_.x); r_[1] = bfhi(q_.x); r_[2] = bflo(q_.y); r_[3] = bfhi(q_.y); r_; })
    for (int i = bid_ * NTHR + tid; i < 512 * (DFF / 4); i += G_ * NTHR) {
        const int S = i / (DFF / 4), c = (i % (DFF / 4)) * 4;
        const int tg = (c >> 7) * 256 + (c & 127), tv = tg + 128;
        const bool first = (S & 127) == 0;
        const bf16_t* h0 = HALO + (size_t)S * 4 * NUP; const bf16_t* hp = HALO + (size_t)(first ? S : S - 1) * 4 * NUP;
        f32x4 g_m2 = HLD(hp + 2 * NUP + tg), g_m1 = HLD(hp + 3 * NUP + tg);
        f32x4 v_m2 = HLD(hp + 2 * NUP + tv), v_m1 = HLD(hp + 3 * NUP + tv);
        const f32x4 g_0 = HLD(h0 + tg), g_1 = HLD(h0 + NUP + tg), v_0 = HLD(h0 + tv), v_1 = HLD(h0 + NUP + tv);
        if (first) { g_m2 = z; g_m1 = z; v_m2 = z; v_m1 = z; }
        const f32x4 wg0 = *(const f32x4*)(cw + c), wg1 = *(const f32x4*)(cw + NUP + c), wg2 = *(const f32x4*)(cw + 2 * NUP + c), bg = *(const f32x4*)(cb + c);
        const f32x4 wv0 = *(const f32x4*)(cw + DFF + c), wv1 = *(const f32x4*)(cw + NUP + DFF + c), wv2 = *(const f32x4*)(cw + 2 * NUP + DFF + c), bv = *(const f32x4*)(cb + DFF + c);
        const f32x4 cg0 = bg + wg0 * g_m2 + wg1 * g_m1 + wg2 * g_0, cv0 = bv + wv0 * v_m2 + wv1 * v_m1 + wv2 * v_0;
        const f32x4 cg1 = bg + wg0 * g_m1 + wg1 * g_0 + wg2 * g_1, cv1 = bv + wv0 * v_m1 + wv1 * v_0 + wv2 * v_1;
        u32x2 w0, w1;
        w0.x = pk2(silu_f(cg0[0]) * cv0[0], silu_f(cg0[1]) * cv0[1]); w0.y = pk2(silu_f(cg0[2]) * cv0[2], silu_f(cg0[3]) * cv0[3]);
        w1.x = pk2(silu_f(cg1[0]) * cv1[0], silu_f(cg1[1]) * cv1[1]); w1.y = pk2(silu_f(cg1[2]) * cv1[2], silu_f(cg1[3]) * cv1[3]);
        *(u32x2*)(ACT + (size_t)(S * 64) * DFF + c) = w0;
        *(u32x2*)(ACT + (size_t)(S * 64 + 1) * DFF + c) = w1;
    }
}

__device__ __forceinline__ void phase_final(const PT& p) {
    int tid = threadIdx.x; asm volatile("" : "+v"(tid));
    int bid_ = blockIdx.x, G_ = gridDim.x; asm volatile("" : "+s"(bid_), "+s"(G_));
    unsigned char* ws = p.ws();
    const bf16_t* SS = (const bf16_t*)(ws + WS_SS); const bf16_t* XB = (const bf16_t*)(ws + WS_XB);
    const int wave = tid >> 6, lane = tid & 63;
    float* outp = p.out(); const float* fg = p.final_g();
    f32x4 g[4];
#pragma unroll
    for (int i = 0; i < 2; ++i) { g[2 * i] = *(const f32x4*)(fg + i * 512 + lane * 8); g[2 * i + 1] = *(const f32x4*)(fg + i * 512 + lane * 8 + 4); }
    const int rstride = G_ * 8;
    for (int row0 = bid_ * 8 + wave; row0 < MTOK; row0 += 8 * rstride) {
        u32x4 r[8][2]; float rs[8];
#pragma unroll
        for (int q = 0; q < 8; ++q) {
            const int row = (row0 + q * rstride < MTOK) ? row0 + q * rstride : row0;
            rs[q] = rstd_from_ss(SS, row);
#pragma unroll
            for (int i = 0; i < 2; ++i) r[q][i] = *(const u32x4*)(XB + (size_t)row * DM + i * 512 + lane * 8);
        }
#pragma unroll
        for (int q = 0; q < 8; ++q) {
            const int row = row0 + q * rstride;
            if (row < MTOK) {
#pragma unroll
                for (int i = 0; i < 2; ++i) {
                    f32x4 v0, v1; v0[0] = bflo(r[q][i].x); v0[1] = bfhi(r[q][i].x); v0[2] = bflo(r[q][i].y); v0[3] = bfhi(r[q][i].y);
                    v1[0] = bflo(r[q][i].z); v1[1] = bfhi(r[q][i].z); v1[2] = bflo(r[q][i].w); v1[3] = bfhi(r[q][i].w);
                    float* op = outp + (size_t)row * DM + i * 512 + lane * 8;
                    *(f32x4*)op = v0 * rs[q] * g[2 * i];
                    *(f32x4*)(op + 4) = v1 * rs[q] * g[2 * i + 1];
                }
            }
        }
    }
}

template <int l>
__device__ __forceinline__ void run_layer(const PT& pt, unsigned char* lds, LAS unsigned char* ldsl, cg::grid_group& grid) {
        {
            unsigned char* ws = pt.ws();
            pg8::Gemm g{(const bf16_t*)(ws + WS_XB), (const bf16_t*)(ws + WS_WIN) + (size_t)l * NIN * DM, MTOK, NIN, DM};
            int bid_ = blockIdx.x, G_ = gridDim.x; asm volatile("" : "+s"(bid_), "+s"(G_)); pg8::StaticOrder S; S.init(MTOK, NIN, G_, bid_, 1);
            EpiProj E{(bf16_t*)(ws + WS_PROJ), (const bf16_t*)(ws + WS_SS)};
            pg8::gemm_phase<EpiProj, pg8::StaticOrder>(ldsl, g, S, E);
            if (DUP_G13) pg8::gemm_phase<EpiProj, pg8::StaticOrder>(ldsl, g, S, E);
            if (l == 0 && G_ == 256 && bid_ >= 128) {
                int tid_ = threadIdx.x; asm volatile("" : "+v"(tid_));
                for (int job = bid_ - 128; job < 768; job += 128)
                    wconv_job((float*)lds, ws, pt.raw(2), pt.raw(9), pt.raw(11), pt.raw(14), pt.raw(1), pt.raw(10), 1, job, tid_);
            }
        }
        GSYNC();
        phase_mix1(pt, lds, l);
        if (DUP_MIX) phase_mix1(pt, lds, l);
        GSYNC();
        phase_scan(pt);
        GSYNC();
        phase_mix3(pt, lds, l);
        if (DUP_MIX) phase_mix3(pt, lds, l);
        GSYNC();
        {
            unsigned char* ws = pt.ws();
            pg8::Gemm g{(const bf16_t*)(ws + WS_Y), (const bf16_t*)(ws + WS_WOUT) + (size_t)l * DM * DM, MTOK, DM, DM};
            int bid_ = blockIdx.x, G_ = gridDim.x; asm volatile("" : "+s"(bid_), "+s"(G_)); pg8::StaticOrder S; S.init(MTOK, DM, G_, bid_);
            EpiRes E{(bf16_t*)(ws + WS_XB), (bf16_t*)(ws + WS_SS)};
            pg8::gemm_phase<EpiRes, pg8::StaticOrder>(ldsl, g, S, E);
        }
        GSYNC();
        {
            unsigned char* ws = pt.ws();
            pg8::Gemm g{(const bf16_t*)(ws + WS_XB), (const bf16_t*)(ws + WS_WUP) + (size_t)l * NUP * DM, MTOK, NUP, DM};
            int bid_ = blockIdx.x, G_ = gridDim.x; asm volatile("" : "+s"(bid_), "+s"(G_)); pg8::StaticOrder S; S.init(MTOK, NUP, G_, bid_, 1);
            EpiUp E{ws, pt.conv_w() + (size_t)l * 3 * NUP, pt.conv_b() + (size_t)l * NUP};
            pg8::gemm_phase<EpiUp, pg8::StaticOrder>(ldsl, g, S, E);
            if (DUP_G13) pg8::gemm_phase<EpiUp, pg8::StaticOrder>(ldsl, g, S, E);
        }
        GSYNC();
        phase_fixup(pt, l);
        if (DUP_MISC) phase_fixup(pt, l);
        GSYNC();
        {
            unsigned char* ws = pt.ws();
            pg8::Gemm g{(const bf16_t*)(ws + WS_PROJ), (const bf16_t*)(ws + WS_WDN) + (size_t)l * DM * DFF, MTOK, DM, DFF};
            int bid_ = blockIdx.x, G_ = gridDim.x; asm volatile("" : "+s"(bid_), "+s"(G_)); pg8::StaticOrder S; S.init(MTOK, DM, G_, bid_);
            EpiRes E{(bf16_t*)(ws + WS_XB), (bf16_t*)(ws + WS_SS)};
            pg8::gemm_phase<EpiRes, pg8::StaticOrder>(ldsl, g, S, E);
        }
        GSYNC();
}

__global__ void __launch_bounds__(NTHR, 2) fwd_megakernel(Params p) {
    extern __shared__ __attribute__((aligned(16))) unsigned char lds[];
    cg::grid_group grid = cg::this_grid();
    LAS unsigned char* ldsl = (LAS unsigned char*)lds;
    {
        LAS unsigned long long* tabw = (LAS unsigned long long*)(ldsl + LDS_TAB);
        if (threadIdx.x == 0) {
            tabw[0] = (unsigned long long)p.x; tabw[1] = (unsigned long long)p.norm1_g; tabw[2] = (unsigned long long)p.w_in; tabw[3] = (unsigned long long)p.a_vnorm_g;
            tabw[4] = (unsigned long long)p.a_ws; tabw[5] = (unsigned long long)p.a_bs; tabw[6] = (unsigned long long)p.b_w; tabw[7] = (unsigned long long)p.b_scale;
            tabw[8] = (unsigned long long)p.c_norm_g; tabw[9] = (unsigned long long)p.w_out; tabw[10] = (unsigned long long)p.norm2_g; tabw[11] = (unsigned long long)p.w_up;
            tabw[12] = (unsigned long long)p.conv_w; tabw[13] = (unsigned long long)p.conv_b; tabw[14] = (unsigned long long)p.w_down; tabw[15] = (unsigned long long)p.final_g;
            tabw[16] = (unsigned long long)p.out; tabw[17] = (unsigned long long)p.ws;
            tabw[24] = 0ull;
        }
    }
    if (blockIdx.x == 0) { unsigned* bw = (unsigned*)(p.ws + WS_BAR); for (int i = threadIdx.x; i < XCD_BAR_WORDS; i += NTHR) bw[i] = 0u; }
    phase_prologue(p, lds);
    if (DUP_MISC) phase_prologue(p, lds);
    grid.sync();
    xcd_barrier_post((unsigned*)(p.ws + WS_BAR));
    PT pt; pt.t = (const LAS unsigned long long*)(ldsl + LDS_TAB);
    run_layer<0>(pt, lds, ldsl, grid);
    run_layer<1>(pt, lds, ldsl, grid);
    phase_final(pt);
    if (DUP_MISC) phase_final(pt);
}

extern "C" void kernel_launch(void* const* d_in, const int* in_sizes, int n_in, void* d_out, int out_size, void* d_ws, size_t ws_size, hipStream_t stream) {
    static int grid_blocks = 0;
    if (grid_blocks == 0) {
        if (n_in != 16 || out_size != MTOK * DM || ws_size < WS_END) { fprintf(stderr, "kernel_launch: unexpected shapes (n_in %d out %d ws %zu need %zu)\n", n_in, out_size, ws_size, (size_t)WS_END); grid_blocks = -1; return; }
        int dev = 0, cus = 0, per_cu = 0;
        (void)hipGetDevice(&dev);
        (void)hipDeviceGetAttribute(&cus, hipDeviceAttributeMultiprocessorCount, dev);
        if (hipFuncSetAttribute((const void*)fwd_megakernel, hipFuncAttributeMaxDynamicSharedMemorySize, LDS_BYTES) != hipSuccess) { fprintf(stderr, "kernel_launch: hipFuncSetAttribute failed\n"); grid_blocks = -1; return; }
        if (hipOccupancyMaxActiveBlocksPerMultiprocessor(&per_cu, (const void*)fwd_megakernel, NTHR, LDS_BYTES) != hipSuccess || per_cu < 1) { fprintf(stderr, "kernel_launch: occupancy query says %d\n", per_cu); grid_blocks = -1; return; }
        grid_blocks = cus * (per_cu > 1 ? 1 : per_cu);
    }
    if (grid_blocks < 0) return;
    Params p{};
    p.x = (const float*)d_in[0]; p.norm1_g = (const float*)d_in[1]; p.w_in = (const float*)d_in[2]; p.a_vnorm_g = (const float*)d_in[3];
    p.a_ws = (const float*)d_in[4]; p.a_bs = (const float*)d_in[5]; p.b_w = (const float*)d_in[6]; p.b_scale = (const float*)d_in[7];
    p.c_norm_g = (const float*)d_in[8]; p.w_out = (const float*)d_in[9]; p.norm2_g = (const float*)d_in[10]; p.w_up = (const float*)d_in[11];
    p.conv_w = (const float*)d_in[12]; p.conv_b = (const float*)d_in[13]; p.w_down = (const float*)d_in[14]; p.final_g = (const float*)d_in[15];
    p.out = (float*)d_out; p.ws = (unsigned char*)d_ws;
    void* args[] = {&p};
    hipError_t e = hipLaunchCooperativeKernel((const void*)fwd_megakernel, dim3(grid_blocks), dim3(NTHR), args, LDS_BYTES, stream);
    if (e != hipSuccess) fprintf(stderr, "cooperative launch failed: %s (grid %d)\n", hipGetErrorString(e), grid_blocks);
}
```
